# Optimizing an MI355X kernel written in HIP

```python
import jax, jax.numpy as jnp
from jax import lax
import numpy as np

D_MODEL = 2048
BATCH = 4
SEQ = 4096
DEPTH = 1

CHUNK = 64
Q_BLOCK = 128
EPS = 1e-6

DN_HEADS = 8
DN_DK = 128
DN_DV = 128
CONV_K = 4
FOX_HEADS = 8
FOX_DH = 128

DN_QK = DN_HEADS * DN_DK
DN_V = DN_HEADS * DN_DV
FOX_W = FOX_HEADS * FOX_DH
MIX_WIDTH = DN_V + FOX_W
CONV_CH = 2 * DN_QK + DN_V
IN_SIZES = (DN_QK, DN_QK, DN_V, DN_V, DN_HEADS, DN_HEADS, FOX_W, FOX_W, FOX_W, FOX_HEADS)
IN_WIDTH = 2 * DN_QK + 2 * DN_V + 2 * DN_HEADS + 3 * FOX_W + FOX_HEADS

N_GROUPS = 4
EXPERTS_PER_GROUP = 8
TOP_K = 2
D_EXPERT = 512

kernel_name = 'hybrid_deltanet_fox_hmoe_block'


def rmsnorm(x, g):
    x32 = x.astype(jnp.float32)
    r = lax.rsqrt(jnp.mean(x32 * x32, axis=-1, keepdims=True) + EPS)
    return (x32 * r).astype(x.dtype) * g


def l2norm(x):
    x32 = x.astype(jnp.float32)
    return x32 * lax.rsqrt(jnp.sum(x32 * x32, axis=-1, keepdims=True) + EPS)


def split_cols(u, sizes):
    points, acc = [], 0
    for s in sizes[:-1]:
        acc += s
        points.append(acc)
    return jnp.split(u, points, axis=-1)


def causal_conv_silu(u, w):
    t = u.shape[1]
    up = jnp.pad(u, ((0, 0), (CONV_K - 1, 0), (0, 0)))
    y = up[:, 0:t] * w[0]
    for j in range(1, CONV_K):
        y = y + up[:, j:j + t] * w[j]
    return jax.nn.silu(y)


def gated_delta_rule(q, k, v, g, beta):
    b, t, h, dk = q.shape
    dv = v.shape[-1]
    nc = t // CHUNK
    f32 = jnp.float32

    def blk(u):
        return u.reshape(b, nc, CHUNK, h, -1).transpose(0, 3, 1, 2, 4).astype(f32)

    qc = blk(q) * (dk ** -0.5)
    kc = blk(k)
    vc = blk(v)
    gch = g.astype(f32).reshape(b, nc, CHUNK, h).transpose(0, 3, 1, 2)
    bch = beta.astype(f32).reshape(b, nc, CHUNK, h).transpose(0, 3, 1, 2)
    gc = jnp.cumsum(gch, axis=-1)
    idx = jnp.arange(CHUNK)
    incl = idx[:, None] >= idx[None, :]
    strict = idx[:, None] > idx[None, :]
    decay = jnp.exp(jnp.where(incl, gc[..., :, None] - gc[..., None, :], -jnp.inf))
    kb = kc * bch[..., None]
    a = jnp.where(strict, jnp.einsum('bhnid,bhnjd->bhnij', kb, kc) * decay, 0.0)
    eye = jnp.broadcast_to(jnp.eye(CHUNK, dtype=f32), a.shape)
    t_inv = lax.linalg.triangular_solve(eye + a, eye, left_side=True, lower=True, unit_diagonal=True)
    u_val = jnp.einsum('bhnij,bhnjd->bhnid', t_inv, vc * bch[..., None])
    w_key = jnp.einsum('bhnij,bhnjd->bhnid', t_inv, kb * jnp.exp(gc)[..., None])
    qk = jnp.where(incl, jnp.einsum('bhnid,bhnjd->bhnij', qc, kc) * decay, 0.0)
    g_last = gc[..., -1:]
    q_dec = qc * jnp.exp(gc)[..., None]
    k_dec = kc * jnp.exp(g_last - gc)[..., None]
    last = jnp.exp(g_last[..., 0])
    xs = tuple(jnp.moveaxis(z, 2, 0) for z in (q_dec, qk, u_val, w_key, k_dec, last))

    def step(s, inp):
        qd, a_in, u_in, w_in, kd, lst = inp
        v_new = u_in - jnp.einsum('bhcd,bhde->bhce', w_in, s)
        o = jnp.einsum('bhcd,bhde->bhce', qd, s) + jnp.einsum('bhij,bhje->bhie', a_in, v_new)
        s = s * lst[..., None, None] + jnp.einsum('bhcd,bhce->bhde', kd, v_new)
        return s, o

    s0 = jnp.zeros((b, h, dk, dv), f32)
    _, o = lax.scan(step, s0, xs)
    return o.transpose(1, 0, 3, 2, 4).reshape(b, t, h, dv)


def forgetting_attention(q, k, v, f_logit):
    b, t, h, d = q.shape
    nb = t // Q_BLOCK
    scale = d ** -0.5
    qh = q.transpose(0, 2, 1, 3)
    kh = k.transpose(0, 2, 1, 3)
    vh = v.transpose(0, 2, 1, 3)
    cum_f = jnp.cumsum(jax.nn.log_sigmoid(f_logit.astype(jnp.float32)), axis=1).transpose(0, 2, 1)
    qb = qh.reshape(b, h, nb, Q_BLOCK, d).transpose(2, 0, 1, 3, 4)
    fb = cum_f.reshape(b, h, nb, Q_BLOCK).transpose(2, 0, 1, 3)
    starts = jnp.arange(nb) * Q_BLOCK
    kpos = jnp.arange(t)

    def one_block(args):
        qi, fi, s0 = args
        logits = jnp.einsum('bhqd,bhkd->bhqk', qi, kh).astype(jnp.float32) * scale
        logits = logits + (fi[..., :, None] - cum_f[..., None, :])
        qpos = s0 + jnp.arange(Q_BLOCK)
        logits = jnp.where(kpos[None, :] <= qpos[:, None], logits, -jnp.inf)
        p = jax.nn.softmax(logits, axis=-1).astype(vh.dtype)
        return jnp.einsum('bhqk,bhkd->bhqd', p, vh)

    o = lax.map(one_block, (qb, fb, starts))
    return o.transpose(1, 0, 3, 2, 4).reshape(b, t, h * d)


def hierarchical_moe(h, w_rg, b_rg, w_re, b_re, w1, w3, w2):
    b, t, d = h.shape
    hf = h.reshape(-1, d)
    n = hf.shape[0]
    gl = (hf @ w_rg + b_rg).astype(jnp.float32)
    gp = jax.nn.softmax(gl, axis=-1)
    _, gidx = lax.top_k(gl, 1)
    pg = jnp.take_along_axis(gp, gidx, axis=1)
    el = (hf @ w_re + b_re).astype(jnp.float32).reshape(n, N_GROUPS, EXPERTS_PER_GROUP)
    el_sel = jnp.take_along_axis(el, gidx[:, :, None], axis=1)[:, 0]
    tv, ti = lax.top_k(el_sel, TOP_K)
    tw = jax.nn.softmax(tv, axis=-1) * pg
    within = jnp.sum(jax.nn.one_hot(ti, EXPERTS_PER_GROUP, dtype=jnp.float32) * tw[..., None], axis=1)
    combine = (jax.nn.one_hot(gidx[:, 0], N_GROUPS, dtype=jnp.float32)[:, :, None] * within[:, None, :]).astype(h.dtype)
    y = jnp.zeros_like(hf)
    for gi in range(N_GROUPS):
        hid = jax.nn.silu(jnp.einsum('nd,edf->nef', hf, w1[gi])) * jnp.einsum('nd,edf->nef', hf, w3[gi])
        y = y + jnp.einsum('nef,efd->nd', hid * combine[:, gi, :, None], w2[gi])
    return y.reshape(b, t, d)


def setup_inputs(seed: int = 0) -> dict:
    key = jax.random.key(seed)
    ks = jax.random.split(key, 24)
    f32 = jnp.float32
    L, D = DEPTH, D_MODEL
    nrm = lambda k_, shape, fan: jax.random.normal(k_, shape, f32) * (fan ** -0.5)
    dt = jax.random.uniform(ks[8], (L, DN_HEADS), f32, 0.001, 0.1)
    return {
        'x': jax.random.normal(ks[0], (BATCH, SEQ, D), f32),
        'c': jax.random.normal(ks[1], (BATCH, D), f32),
        'w_ada': nrm(ks[2], (L, D, 6 * D), D),
        'b_ada': 0.01 * jax.random.normal(ks[3], (L, 6 * D), f32),
        'norm1_g': 1.0 + 0.01 * jax.random.normal(ks[4], (L, D), f32),
        'w_in': nrm(ks[5], (L, D, IN_WIDTH), D),
        'conv_w': nrm(ks[6], (L, CONV_K, CONV_CH), CONV_K),
        'a_log': jnp.log(jax.random.uniform(ks[7], (L, DN_HEADS), f32, 1.0, 16.0)),
        'dt_bias': dt + jnp.log(-jnp.expm1(-dt)),
        'dn_onorm_g': 1.0 + 0.01 * jax.random.normal(ks[9], (L, DN_DV), f32),
        'fox_f_bias': jax.random.uniform(ks[10], (L, FOX_HEADS), f32, 1.0, 3.0),
        'w_out': nrm(ks[11], (L, MIX_WIDTH, D), MIX_WIDTH),
        'norm2_g': 1.0 + 0.01 * jax.random.normal(ks[12], (L, D), f32),
        'w_router_group': nrm(ks[13], (L, D, N_GROUPS), D),
        'b_router_group': 0.01 * jax.random.normal(ks[14], (L, N_GROUPS), f32),
        'w_router_expert': nrm(ks[15], (L, D, N_GROUPS * EXPERTS_PER_GROUP), D),
        'b_router_expert': 0.01 * jax.random.normal(ks[16], (L, N_GROUPS * EXPERTS_PER_GROUP), f32),
        'w1': nrm(ks[17], (L, N_GROUPS, EXPERTS_PER_GROUP, D, D_EXPERT), D),
        'w3': nrm(ks[18], (L, N_GROUPS, EXPERTS_PER_GROUP, D, D_EXPERT), D),
        'w2': nrm(ks[19], (L, N_GROUPS, EXPERTS_PER_GROUP, D_EXPERT, D), D_EXPERT),
        'final_g': 1.0 + 0.01 * jax.random.normal(ks[20], (D,), f32),
    }


def reference(x, c, w_ada, b_ada, norm1_g, w_in, conv_w, a_log, dt_bias, dn_onorm_g, fox_f_bias,
              w_out, norm2_g, w_router_group, b_router_group, w_router_expert, b_router_expert,
              w1, w3, w2, final_g):
    b, t, _ = x.shape
    for l in range(DEPTH):
        mod = jax.nn.silu(c) @ w_ada[l] + b_ada[l]
        sh1, sc1, g1, sh2, sc2, g2 = jnp.split(mod[:, None, :], 6, axis=-1)

        h = rmsnorm(x, norm1_g[l]) * (1.0 + sc1) + sh1
        proj = h @ w_in[l]
        q_a, k_a, v_a, z_a, a_a, b_a, q_b, k_b, v_b, f_b = split_cols(proj, IN_SIZES)

        qkv = causal_conv_silu(jnp.concatenate([q_a, k_a, v_a], axis=-1), conv_w[l])
        q_a, k_a, v_a = split_cols(qkv, (DN_QK, DN_QK, DN_V))
        q_a = l2norm(q_a.reshape(b, t, DN_HEADS, DN_DK))
        k_a = l2norm(k_a.reshape(b, t, DN_HEADS, DN_DK))
        v_a = v_a.reshape(b, t, DN_HEADS, DN_DV)
        g_dec = -jnp.exp(a_log[l].astype(jnp.float32)) * jax.nn.softplus(a_a.astype(jnp.float32) + dt_bias[l])
        beta = jax.nn.sigmoid(b_a.astype(jnp.float32))
        o_a = gated_delta_rule(q_a, k_a, v_a, g_dec, beta).astype(x.dtype)
        o_a = rmsnorm(o_a, dn_onorm_g[l]) * jax.nn.silu(z_a.reshape(b, t, DN_HEADS, DN_DV))
        o_a = o_a.reshape(b, t, DN_V)

        o_b = forgetting_attention(q_b.reshape(b, t, FOX_HEADS, FOX_DH),
                                   k_b.reshape(b, t, FOX_HEADS, FOX_DH),
                                   v_b.reshape(b, t, FOX_HEADS, FOX_DH),
                                   f_b + fox_f_bias[l])

        mix = jnp.concatenate([o_a, o_b.astype(x.dtype)], axis=-1) @ w_out[l]
        x = x + g1 * mix

        h2 = rmsnorm(x, norm2_g[l]) * (1.0 + sc2) + sh2
        x = x + g2 * hierarchical_moe(h2, w_router_group[l], b_router_group[l],
                                      w_router_expert[l], b_router_expert[l],
                                      w1[l], w3[l], w2[l])
    return rmsnorm(x, final_g)
```

```cpp
#include <hip/hip_runtime.h>
#include <cstdio>
#include <cstdint>
namespace pg8 {
#define PG8_LAS __attribute__((address_space(3)))
typedef unsigned short bf16_t;
typedef short bf16x8 __attribute__((ext_vector_type(8)));
typedef float f32x4 __attribute__((ext_vector_type(4)));
typedef unsigned u32x4 __attribute__((ext_vector_type(4)));
constexpr int BM = 256, BK = 64, HALF = 128, HTB = HALF * BK * 2  , STAGE_BYTES = 8 * HTB, NXCD = 8, WGM = 8;

__host__ __device__ __forceinline__ int lds_byte(int r, int c) { const int st = (r >> 4) * 2 + (c >> 5), rr = r & 15, cc = c & 31, ob = rr * 64 + cc * 2; return st * 1024 + (ob ^ (((ob >> 9) & 1) << 5)); }
__host__ __device__ __forceinline__ void stage_rc(int b, int& R, int& C) { const int st = b / 1024, sb = b % 1024, swz = sb ^ (((sb >> 9) & 1) << 5); R = (st >> 1) * 16 + swz / 64; C = (st & 1) * 32 + (swz % 64) / 2; }
__host__ __device__ __forceinline__ int perm32(int rho) { const int n = rho >> 4, i = rho & 15; return 8 * (i >> 2) + 4 * n + (i & 3); }

struct Unit { int pm, pn; };
struct Gemm { const bf16_t* A; const bf16_t* Bt; int M, N, K; };

struct StaticOrder {
    int nM, nN, nwg, G, c;
    __host__ __device__ void init(int M, int N, int G_, int c_) { nM = M / BM; nN = N / BM; nwg = nM * nN; G = G_; c = c_; }
    __host__ __device__ bool next(int i, Unit& u) const {
        const long L = (long)i * G + c; if (L >= nwg) return false;
        int wgid = (int)L; { const int q = nwg / NXCD, r = nwg % NXCD, xcd = wgid % NXCD, off = wgid / NXCD; wgid = (xcd < r ? xcd * (q + 1) : r * (q + 1) + (xcd - r) * q) + off; }
        const int nig = WGM * nN, gid = wgid / nig, fm = gid * WGM, gsz = (nM - fm) < WGM ? (nM - fm) : WGM;
        u.pm = fm + ((wgid % nig) % gsz); u.pn = (wgid % nig) / gsz; return true;
    }
    __device__ __forceinline__ void a_ready(const Unit&) const {}
    __device__ __forceinline__ void done(const Unit&) const {}
};
__device__ __forceinline__ unsigned cvt_pk_bf16(float lo, float hi) { unsigned r; asm volatile("v_cvt_pk_bf16_f32 %0, %1, %2" : "=v"(r) : "v"(lo), "v"(hi)); return r; }
typedef unsigned u32x2 __attribute__((ext_vector_type(2)));
template <class Epi, class Sched, bool ALIGN_EPI = false, bool SP2 = false>
__device__ __forceinline__ void gemm_phase(PG8_LAS unsigned char* lds, const Gemm g, const Sched& S, const Epi& E) {
    const int tid = threadIdx.x, wid = __builtin_amdgcn_readfirstlane(tid >> 6), lane = tid & 63, wr = wid >> 2, wc = wid & 3, fr = lane & 15, fq = lane >> 4;
    const int K = g.K, nt = K / BK;
    unsigned voffA[2], voffB[2];
#pragma unroll
    for (int i = 0; i < 2; ++i) { int R, C; stage_rc(tid * 16 + i * 8192, R, C); const int Rb = Epi::PERM ? ((R & ~31) + perm32(R & 31)) : R;
        voffA[i] = (unsigned)(R * K + C) * 2u; voffB[i] = (unsigned)(Rb * K + C) * 2u; }
    const size_t kstep = (size_t)(BK * 2);
    const size_t hstep = (size_t)HALF * K * 2;
    const size_t tstep = 2 * hstep;
    const unsigned ldsw = (unsigned)wid * 1024u;
    const int aoff = lds_byte(wr * 64 + fr, fq * 8), boff = lds_byte(wc * 32 + fr, fq * 8);
#define PG8_SA(b, h) (((b) * 2 + (h)) * HTB)
#define PG8_SB(b, h) ((4 + (b) * 2 + (h)) * HTB)
#define PG8_STAGE(bufoff, gbase, voff) do { _Pragma("unroll") for (int _i = 0; _i < 2; ++_i) \
        __builtin_amdgcn_global_load_lds((const unsigned*)((const char*)(gbase) + (voff)[_i]), (PG8_LAS unsigned*)(lds + (bufoff) + ldsw + _i * 8192), 16, 0, 0); } while (0)
#define PG8_LDA(dst, b, h) do { _Pragma("unroll") for (int m = 0; m < 4; ++m) _Pragma("unroll") for (int k = 0; k < 2; ++k) dst[m][k] = *(const PG8_LAS bf16x8*)(lds + PG8_SA(b, h) + aoff + m * 2048 + k * 1024); } while (0)
#define PG8_LDB(dst, b, h) do { _Pragma("unroll") for (int n = 0; n < 2; ++n) _Pragma("unroll") for (int k = 0; k < 2; ++k) dst[n][k] = *(const PG8_LAS bf16x8*)(lds + PG8_SB(b, h) + boff + n * 2048 + k * 1024); } while (0)
#define PG8_MMA(ai, bj, At, Bt) do { __builtin_amdgcn_s_setprio(1); _Pragma("unroll") for (int m = 0; m < 4; ++m) _Pragma("unroll") for (int n = 0; n < 2; ++n) _Pragma("unroll") for (int k = 0; k < 2; ++k) \
        acc[ai][bj][m][n] = __builtin_amdgcn_mfma_f32_16x16x32_bf16(Bt[n][k], At[m][k], acc[ai][bj][m][n], 0, 0, 0); __builtin_amdgcn_s_setprio(0); } while (0)
#define PG8_WAIT_V(n) asm volatile("s_waitcnt vmcnt(" #n ")" ::: "memory")
#define PG8_WAIT_L(n) asm volatile("s_waitcnt lgkmcnt(" #n ")" ::: "memory")
#define PG8_BAR __builtin_amdgcn_s_barrier()
#define PG8_SCHED __builtin_amdgcn_sched_barrier(0)
    Unit cur, nxt; int ui = 0;
    if (!S.next(0, cur)) return;
    f32x4 acc[2][2][4][2];
#pragma unroll
    for (int a = 0; a < 2; ++a)
#pragma unroll
        for (int b = 0; b < 2; ++b)
#pragma unroll
            for (int m = 0; m < 4; ++m)
#pragma unroll
                for (int n = 0; n < 2; ++n) acc[a][b][m][n] = (f32x4){0.f, 0.f, 0.f, 0.f};
    bf16x8 At[4][2], B0[2][2], B1[2][2];
    const char* cA = (const char*)g.A + (size_t)cur.pm * tstep; const char* cB = (const char*)g.Bt + (size_t)cur.pn * tstep;
    S.a_ready(cur);
    if constexpr (SP2) {
        PG8_STAGE(PG8_SB(0, 0), cB, voffB); PG8_STAGE(PG8_SB(0, 1), cB + hstep, voffB); PG8_STAGE(PG8_SA(0, 0), cA, voffA); PG8_STAGE(PG8_SA(0, 1), cA + hstep, voffA);
        if (wr == 1) PG8_BAR;
        PG8_WAIT_V(2); PG8_BAR;
        PG8_STAGE(PG8_SB(1, 0), cB + kstep, voffB); PG8_STAGE(PG8_SA(1, 0), cA + kstep, voffA); PG8_STAGE(PG8_SB(1, 1), cB + hstep + kstep, voffB);
        PG8_WAIT_V(6); PG8_BAR;
    } else {
        PG8_STAGE(PG8_SB(0, 0), cB, voffB); PG8_STAGE(PG8_SA(0, 0), cA, voffA); PG8_STAGE(PG8_SB(0, 1), cB + hstep, voffB); PG8_STAGE(PG8_SA(0, 1), cA + hstep, voffA);
        if (wr == 1) PG8_BAR;
        PG8_WAIT_V(4); PG8_BAR;
        PG8_STAGE(PG8_SB(1, 0), cB + kstep, voffB); PG8_STAGE(PG8_SA(1, 0), cA + kstep, voffA); PG8_STAGE(PG8_SB(1, 1), cB + hstep + kstep, voffB);
        PG8_WAIT_V(6); PG8_BAR;
    }
    for (;;) {
        const bool has_next = S.next(ui + 1, nxt);
        const char* nA = has_next ? (const char*)g.A + (size_t)nxt.pm * tstep : cA; const char* nB = has_next ? (const char*)g.Bt + (size_t)nxt.pn * tstep : cB;
        for (int t = 0; t < nt; t += 2) {
            const bool last = (t == nt - 2);
            const char* a1 = cA + (size_t)(t + 1) * kstep;
            const char* a2 = last ? nA : cA + (size_t)(t + 2) * kstep; const char* b2 = last ? nB : cB + (size_t)(t + 2) * kstep;
            const char* a3 = a2 + kstep; const char* b3 = b2 + kstep;
            if (last && has_next) S.a_ready(nxt);
            if constexpr (SP2) {
            PG8_LDB(B0, 0, 0); PG8_LDB(B1, 0, 1); PG8_SCHED; PG8_LDA(At, 0, 0); PG8_STAGE(PG8_SA(1, 1), a1 + hstep, voffA);
            PG8_WAIT_V(8); PG8_WAIT_L(0); PG8_BAR; PG8_MMA(0, 0, At, B0); PG8_MMA(0, 1, At, B1); PG8_BAR; PG8_SCHED;
            PG8_LDA(At, 0, 1); PG8_STAGE(PG8_SB(0, 0), b2, voffB); PG8_STAGE(PG8_SB(0, 1), b2 + hstep, voffB); PG8_STAGE(PG8_SA(0, 0), a2, voffA);
            PG8_WAIT_V(8); PG8_WAIT_L(0); PG8_BAR; PG8_MMA(1, 0, At, B0); PG8_MMA(1, 1, At, B1); PG8_BAR; PG8_SCHED;
            PG8_LDB(B0, 1, 0); PG8_LDB(B1, 1, 1); PG8_SCHED; PG8_LDA(At, 1, 0); PG8_STAGE(PG8_SA(0, 1), a2 + hstep, voffA);
            PG8_WAIT_V(8); PG8_WAIT_L(0); PG8_BAR; PG8_MMA(0, 0, At, B0); PG8_MMA(0, 1, At, B1); PG8_BAR; PG8_SCHED;
            PG8_LDA(At, 1, 1); PG8_STAGE(PG8_SB(1, 0), b3, voffB); PG8_STAGE(PG8_SB(1, 1), b3 + hstep, voffB); PG8_STAGE(PG8_SA(1, 0), a3, voffA);
            PG8_WAIT_V(8); PG8_WAIT_L(0); PG8_BAR; PG8_MMA(1, 0, At, B0); PG8_MMA(1, 1, At, B1); PG8_BAR; PG8_SCHED;
            } else {
            PG8_LDB(B0, 0, 0); PG8_SCHED; PG8_LDA(At, 0, 0); PG8_STAGE(PG8_SA(1, 1), a1 + hstep, voffA);
            PG8_WAIT_L(8); PG8_BAR; PG8_WAIT_L(0); PG8_MMA(0, 0, At, B0); PG8_BAR; PG8_SCHED;
            PG8_LDB(B1, 0, 1); PG8_STAGE(PG8_SB(0, 0), b2, voffB);
            PG8_BAR; PG8_WAIT_L(0); PG8_MMA(0, 1, At, B1); PG8_BAR;
            PG8_LDA(At, 0, 1); PG8_STAGE(PG8_SA(0, 0), a2, voffA);
            PG8_BAR; PG8_WAIT_L(0); PG8_MMA(1, 0, At, B0); PG8_BAR; PG8_SCHED;
            PG8_STAGE(PG8_SB(0, 1), b2 + hstep, voffB);
            PG8_WAIT_V(6); PG8_BAR; PG8_MMA(1, 1, At, B1); PG8_BAR;
            PG8_LDB(B0, 1, 0); PG8_SCHED; PG8_LDA(At, 1, 0); PG8_STAGE(PG8_SA(0, 1), a2 + hstep, voffA);
            PG8_WAIT_L(8); PG8_BAR; PG8_WAIT_L(0); PG8_MMA(0, 0, At, B0); PG8_BAR; PG8_SCHED;
            PG8_LDB(B1, 1, 1); PG8_STAGE(PG8_SB(1, 0), b3, voffB);
            PG8_BAR; PG8_WAIT_L(0); PG8_MMA(0, 1, At, B1); PG8_BAR;
            PG8_LDA(At, 1, 1); PG8_STAGE(PG8_SA(1, 0), a3, voffA);
            PG8_BAR; PG8_WAIT_L(0); PG8_MMA(1, 0, At, B0); PG8_BAR; PG8_SCHED;
            PG8_STAGE(PG8_SB(1, 1), b3 + hstep, voffB);
            PG8_WAIT_V(6); PG8_BAR; PG8_MMA(1, 1, At, B1); PG8_BAR;
            }
        }
        if constexpr (ALIGN_EPI) { if (wr == 0) PG8_BAR; }
        if constexpr (!Epi::AFTER_DRAIN) { E(acc, cur, wr, wc, fr, fq); S.done(cur); }
        if (!has_next) break;
#pragma unroll
        for (int a = 0; a < 2; ++a)
#pragma unroll
            for (int b = 0; b < 2; ++b)
#pragma unroll
                for (int m = 0; m < 4; ++m)
#pragma unroll
                    for (int n = 0; n < 2; ++n) acc[a][b][m][n] = (f32x4){0.f, 0.f, 0.f, 0.f};
        cur = nxt; cA = nA; cB = nB; ++ui;
        if constexpr (ALIGN_EPI) { if (wr == 1) PG8_BAR; }
    }
    PG8_WAIT_V(0);
    if constexpr (!ALIGN_EPI) { if (wr == 0) PG8_BAR; }
    PG8_BAR;
    if constexpr (Epi::AFTER_DRAIN) { E.fused(acc, cur, wr, wc, fr, fq, lds, wid, lane); S.done(cur); }
#undef PG8_SA
#undef PG8_SB
#undef PG8_STAGE
#undef PG8_LDA
#undef PG8_LDB
#undef PG8_MMA
#undef PG8_WAIT_V
#undef PG8_WAIT_L
#undef PG8_BAR
#undef PG8_SCHED
}
}

constexpr int NWAVES = 8, NTHR = 512;
constexpr int BATCH = 4, SEQ = 4096, D = 2048, M = BATCH * SEQ;
constexpr int NH = 8, HD = 128;
constexpr int INW = 7192, NBIG = 7168;
constexpr int CONVCH = 3072;
constexpr int NG = 4, EPG = 8, NE = 32, DE = 512;
constexpr float EPS = 1e-6f;
constexpr int CHUNK = 64, NCH = SEQ / CHUNK;
constexpr int SLOT_CAP = 40960;

constexpr size_t MiB = 1u << 20;
constexpr size_t WS_CTL = 0, CTL_ZERO_BYTES = 1 * MiB;
constexpr size_t WS_WST = 1 * MiB;
constexpr size_t WS_WRT = 1 * MiB + 256 * 1024;
constexpr size_t WS_SMALL = 2 * MiB;
constexpr size_t WS_WINT = 4 * MiB;
constexpr size_t WS_WOUTT = 32 * MiB;
constexpr size_t WS_H = 40 * MiB;
constexpr size_t WS_QKVA = 104 * MiB;
constexpr size_t WS_Z = 200 * MiB;
constexpr size_t WS_QKVB = 232 * MiB;
constexpr size_t QKVB_STRIDE = (size_t)M * 1024;
constexpr size_t WS_RD = 328 * MiB;
constexpr size_t WS_CUMF = 592 * MiB;
constexpr size_t WS_RL = 593 * MiB;
constexpr size_t WS_ROUTE = 597 * MiB;
constexpr size_t WS_END = 600 * MiB;
constexpr size_t WS_W13T = 104 * MiB;
constexpr size_t WS_W2T = 328 * MiB;
constexpr size_t WS_HID = 392 * MiB;
constexpr size_t WS_Y = 432 * MiB;
static_assert(WS_HID + (size_t)SLOT_CAP * 512 * 2 <= WS_Y, "hid");
constexpr size_t RT_TOKE = 0;
constexpr size_t RT_TOKW = 128 * 1024;
constexpr size_t RT_TOKR = 256 * 1024;
constexpr size_t RT_LIST = 384 * 1024;
constexpr size_t RT_SLOTW = 640 * 1024;
constexpr int CW_TMO = 0, CW_CODE = 1;
constexpr int CW_BAR = 4096;
constexpr int CW_CNT = 8192;
constexpr int CW_MOD = 65536;
static_assert((CW_MOD + 4 * 12288) * 4 <= (int)CTL_ZERO_BYTES, "ctl");

constexpr int RING_BYTES = 131072;
constexpr int LDSCTL_OFF = RING_BYTES, MISC_OFF = LDSCTL_OFF + 320;
constexpr int LDS_BYTES = 147456;

#define GAS __attribute__((address_space(1)))
#define LAS __attribute__((address_space(3)))
typedef unsigned short bf16;
typedef unsigned v4u __attribute__((ext_vector_type(4)));
typedef unsigned v2u __attribute__((ext_vector_type(2)));
typedef float f32x4 __attribute__((ext_vector_type(4)));
typedef float f32x2 __attribute__((ext_vector_type(2)));
typedef short bf16x8 __attribute__((ext_vector_type(8)));
typedef GAS unsigned gu32;
#define RLX_AGENT __ATOMIC_RELAXED, __HIP_MEMORY_SCOPE_AGENT
#define LDS_WAIT() asm volatile("s_waitcnt lgkmcnt(0)" ::: "memory")
#define VM_WAIT() asm volatile("s_waitcnt vmcnt(0)" ::: "memory")
__device__ __forceinline__ unsigned f2bf(float f) { unsigned u = __builtin_bit_cast(unsigned, f); return (u + 0x7fffu + ((u >> 16) & 1u)) >> 16; }
__device__ __forceinline__ unsigned pk2(float lo, float hi) { return f2bf(lo) | (f2bf(hi) << 16); }
__device__ __forceinline__ float bf2f(unsigned short b) { return __builtin_bit_cast(float, ((unsigned)b) << 16); }
__device__ __forceinline__ float bflo(unsigned w) { return __builtin_bit_cast(float, w << 16); }
__device__ __forceinline__ float bfhi(unsigned w) { return __builtin_bit_cast(float, w & 0xffff0000u); }
__device__ __forceinline__ float wave_sum(float v) {
#pragma unroll
    for (int o = 1; o < 64; o <<= 1) v += __shfl_xor(v, o);
    return v;
}
__device__ __forceinline__ float siluf(float x) { return x / (1.f + __expf(-x)); }
__device__ __forceinline__ float sigmoidf_(float x) { return 1.f / (1.f + __expf(-x)); }
__device__ __forceinline__ float softplusf_(float x) { return x > 20.f ? x : log1pf(expf(x)); }
__device__ __forceinline__ float logsigmoidf_(float x) { return fminf(x, 0.f) - log1pf(expf(-fabsf(x))); }
#define XB_TMO      128
#define XB_XCNT(j)  (256  + 64 * (j))
#define XB_XSUB(j)  (1280 + 64 * (j))
#define XB_XGEN(j)  (2304 + 64 * (j))
#define XB_TOP      3328
#define XB_TOPGEN   3392
#define XCD_BAR_WORDS 3456
#define XB_SPIN_CAP (1u << 18)
#define XB_TMO      128
#define XB_XCNT(j)  (256  + 64 * (j))
#define XB_XSUB(j)  (1280 + 64 * (j))
#define XB_XGEN(j)  (2304 + 64 * (j))
#define XB_TOP      3328
#define XB_TOPGEN   3392
#define XCD_BAR_WORDS 3456
#define XB_SPIN_CAP (1u << 18)

__device__ __forceinline__ unsigned xb_ld(unsigned* p)              { return __hip_atomic_load(p, __ATOMIC_RELAXED, __HIP_MEMORY_SCOPE_AGENT); }
__device__ __forceinline__ unsigned xb_add(unsigned* p, unsigned v) { return __hip_atomic_fetch_add(p, v, __ATOMIC_RELAXED, __HIP_MEMORY_SCOPE_AGENT); }
__device__ __forceinline__ unsigned xb_xcc_id() { return (unsigned)__builtin_amdgcn_s_getreg((3 << 11) | 20) & 0xFu; }
#define XB_SPIN(cond, bar) do { unsigned _sp = 0; while (cond) { __builtin_amdgcn_s_sleep(1); \
    if ((++_sp & 255u) == 0u) { if (xb_ld(&(bar)[XB_TMO])) break; if (_sp > XB_SPIN_CAP) { atomicAdd(&(bar)[XB_TMO], 1u); break; } } } } while (0)

struct XcdBarrier {
    unsigned* bar; unsigned x;
    volatile LAS unsigned* st;
};

__device__ __forceinline__ XcdBarrier xcd_barrier_post(unsigned* bar, volatile LAS unsigned* st) {
    XcdBarrier b; b.bar = bar; b.x = xb_xcc_id(); b.st = st;
    if (threadIdx.x == 0) (void)xb_add(&bar[XB_XCNT(b.x)], 1u);
    return b;
}
__device__ __forceinline__ void xcd_barrier_complete(unsigned* bar, unsigned x, unsigned& nloc, unsigned& nx) {
    const unsigned G = gridDim.x * gridDim.y * gridDim.z;
    unsigned sum, cnt, mine, sp = 0u;
    for (;;) {
        sum = 0u; cnt = 0u; mine = 0u;
#pragma unroll
        for (unsigned j = 0; j < 16; ++j) { const unsigned c = xb_ld(&bar[XB_XCNT(j)]); sum += c; cnt += (c > 0u) ? 1u : 0u; mine = (j == x) ? c : mine; }
        if (sum == G) break;
        __builtin_amdgcn_s_sleep(1);
        if ((++sp & 255u) == 0u) { if (xb_ld(&bar[XB_TMO])) break; if (sp > XB_SPIN_CAP) { atomicAdd(&bar[XB_TMO], 1u); break; } }
    }
    nloc = mine > 0u ? mine : 1u; nx = cnt > 0u ? cnt : 1u;
}

__device__ __forceinline__ void xcd_barrier(const XcdBarrier& b) {
    asm volatile("s_waitcnt vmcnt(0)" ::: "memory");
    __syncthreads();
    if (threadIdx.x == 0) {
        unsigned* bar = b.bar;
        __builtin_amdgcn_s_waitcnt(0);
        unsigned nloc = b.st[0], nx = b.st[1];
        if (nloc == 0u) { xcd_barrier_complete(bar, b.x, nloc, nx); b.st[0] = nloc; b.st[1] = nx; }
        const unsigned old = xb_add(&bar[XB_XSUB(b.x)], 1u);
        const unsigned gen = old / nloc;
        if (old + 1u == (gen + 1u) * nloc) {
            __builtin_amdgcn_fence(__ATOMIC_RELEASE, "agent");
            asm volatile("s_waitcnt vmcnt(0)" ::: "memory");
            const unsigned og = xb_add(&bar[XB_TOP], 1u);
            const unsigned tg = og / nx;
            if (og + 1u == (tg + 1u) * nx) xb_add(&bar[XB_TOPGEN], 1u);
            else XB_SPIN(xb_ld(&bar[XB_TOPGEN]) == tg, bar);
            __builtin_amdgcn_fence(__ATOMIC_ACQUIRE, "agent");
            xb_add(&bar[XB_XGEN(b.x)], 1u);
            asm volatile("s_waitcnt vmcnt(0)" ::: "memory");
        } else {
            XB_SPIN(xb_ld(&bar[XB_XGEN(b.x)]) == gen, bar);
            __builtin_amdgcn_fence(__ATOMIC_ACQUIRE, "agent");
            asm volatile("s_waitcnt vmcnt(0)" ::: "memory");
        }
    }
    __syncthreads();
}

struct Args { const float* in[21]; float* out; unsigned char* ws; int ph_lo, ph_hi; };
struct Frame {
    LAS unsigned char* lds; volatile LAS unsigned* MISC; unsigned* ctl;
    int tid, lane, wave, vcu, G, gw, NGW;
};

struct EpiProj {
    static constexpr bool PERM = true, AFTER_DRAIN = false;
    bf16* QKVA; bf16* Z; bf16* QKVB;
    __device__ __forceinline__ void operator()(const pg8::f32x4 (&acc)[2][2][4][2], const pg8::Unit& u, int wr, int wc, int fr, int fq) const {
        const int row0 = u.pm * 256 + wr * 64 + fr, pn = u.pn, cin = wc * 32 + 8 * fq;
#pragma unroll
        for (int ai = 0; ai < 2; ++ai)
#pragma unroll
            for (int m = 0; m < 4; ++m) { const int row = row0 + ai * 128 + m * 16;
#pragma unroll
                for (int bj = 0; bj < 2; ++bj) { const pg8::f32x4 v0 = acc[ai][bj][m][0], v1 = acc[ai][bj][m][1];
                    v4u w; w.x = pg8::cvt_pk_bf16(v0[0], v0[1]); w.y = pg8::cvt_pk_bf16(v0[2], v0[3]); w.z = pg8::cvt_pk_bf16(v1[0], v1[1]); w.w = pg8::cvt_pk_bf16(v1[2], v1[3]);
                    bf16* dst;
                    if (pn < 12) dst = QKVA + (size_t)row * 3072 + pn * 256 + bj * 128 + cin;
                    else if (pn < 16) dst = Z + (size_t)row * 1024 + (pn - 12) * 256 + bj * 128 + cin;
                    else { const int q = pn - 16, tensor = q >> 2, head = (q & 3) * 2 + bj, b = row >> 12, t = row & 4095;
                        dst = QKVB + (size_t)tensor * QKVB_STRIDE + ((size_t)((b * NH + head) * SEQ + t)) * HD + cin; }
                    *(v4u*)dst = w; } }
    }
};
struct EpiMix {
    static constexpr bool PERM = false, AFTER_DRAIN = false;
    const float* x; const float* mod; float* out;
    __device__ __forceinline__ void operator()(const pg8::f32x4 (&acc)[2][2][4][2], const pg8::Unit& u, int wr, int wc, int fr, int fq) const {
        const int row0 = u.pm * 256 + wr * 64 + fr, col0 = u.pn * 256 + wc * 32 + 4 * fq, b = u.pm >> 4;
        f32x4 gv[2][2];
#pragma unroll
        for (int bj = 0; bj < 2; ++bj)
#pragma unroll
            for (int n = 0; n < 2; ++n) gv[bj][n] = *(const f32x4*)(mod + b * 12288 + 2 * D + col0 + bj * 128 + n * 16);
#pragma unroll
        for (int ai = 0; ai < 2; ++ai)
#pragma unroll
            for (int m = 0; m < 4; ++m) { const size_t off = (size_t)(row0 + ai * 128 + m * 16) * D + col0;
#pragma unroll
                for (int bj = 0; bj < 2; ++bj)
#pragma unroll
                    for (int n = 0; n < 2; ++n) { const f32x4 xv = *(const f32x4*)(x + off + bj * 128 + n * 16);
                        *(f32x4*)(out + off + bj * 128 + n * 16) = xv + gv[bj][n] * acc[ai][bj][m][n]; } }
    }
};

__device__ __forceinline__ void transpose_item(const float* W, int ldw, int csrc, bf16* WT, int ldt, int drow0, int k0, LAS float* scr, int lane, int mode) {
#pragma unroll 8
    for (int i = 0; i < 32; ++i) { const int kk = 2 * i + (lane >> 5); scr[kk * 33 + (lane & 31)] = W[(size_t)(k0 + kk) * ldw + csrc + (lane & 31)]; }
    LDS_WAIT(); asm volatile("" ::: "memory");
    const int c = lane & 7;
#pragma unroll
    for (int j = 0; j < 4; ++j) { const int n = (lane >> 3) + 8 * j; const LAS float* s = scr + (8 * c) * 33 + n;
        v4u o; o.x = pk2(s[0 * 33], s[1 * 33]); o.y = pk2(s[2 * 33], s[3 * 33]); o.z = pk2(s[4 * 33], s[5 * 33]); o.w = pk2(s[6 * 33], s[7 * 33]);
        int dr;
        if (mode == 0) dr = drow0 + n;
        else dr = drow0 + ((n >> 4) << 5) + (n & 15) + (mode == 2 ? 16 : 0);
        *(GAS v4u*)(WT + (size_t)dr * ldt + k0 + 8 * c) = o; }
    LDS_WAIT(); asm volatile("" ::: "memory");
}
__device__ __forceinline__ void p0_prologue(Frame& F, const Args& A) {
    LAS float* scr = (LAS float*)(F.lds + F.wave * 16384);
    unsigned char* ws = A.ws;
    const float* w_in = A.in[5]; const float* w_out = A.in[11];
    bf16* WINT = (bf16*)(ws + WS_WINT); bf16* WOUTT = (bf16*)(ws + WS_WOUTT);
    constexpr int I_G = 32 * 32, I_IN = 7 * I_G, I_OUT = 32 * 64;
    for (int it = F.gw; it < I_IN + I_OUT; it += F.NGW) {
        if (it < I_IN) { const int g = it / I_G, r = it % I_G, kb = r / 32, nb = r % 32;
            const int src0 = (g < 4) ? g * 1024 : 4112 + (g - 4) * 1024;
            transpose_item(w_in, INW, src0 + nb * 32, WINT, D, g * 1024 + nb * 32, kb * 64, scr, F.lane, 0); }
        else { const int r = it - I_IN, kb = r / 64, nb = r % 64;
            transpose_item(w_out, D, nb * 32, WOUTT, D, nb * 32, kb * 64, scr, F.lane, 0); }
    }
    { bf16* WST = (bf16*)(ws + WS_WST); bf16* WRT = (bf16*)(ws + WS_WRT); const float* w_rg = A.in[13]; const float* w_re = A.in[15];
      const int gt = F.vcu * NTHR + F.tid, NT_ = F.G * NTHR;
      for (int i = gt; i < 80 * 2048; i += NT_) { const int n = i >> 11, k = i & 2047;
          if (n < 32) { float v = 0.f; if (n < 8) v = w_in[(size_t)k * INW + 4096 + n]; else if (n < 16) v = w_in[(size_t)k * INW + 4104 + (n - 8)]; else if (n < 24) v = w_in[(size_t)k * INW + 7184 + (n - 16)];
              WST[n * 2048 + k] = (bf16)f2bf(v); }
          else { const int r = n - 32; float v = 0.f; if (r < 4) v = w_rg[k * 4 + r]; else if (r < 36) v = w_re[k * 32 + (r - 4)];
              WRT[r * 2048 + k] = (bf16)f2bf(v); } } }
    { const float* cvec = A.in[1]; const float* w_ada = A.in[2]; const float* b_ada = A.in[3]; float* mod = (float*)(F.ctl + CW_MOD);
      __syncthreads();
      LAS float* sc = (LAS float*)F.lds;
      LAS float* red = sc + 8192;
      for (int i = F.tid; i < 4 * D; i += NTHR) sc[i] = siluf(cvec[i]);
      LDS_WAIT(); __syncthreads();
      const int cl = F.tid & 15, kg = F.tid >> 4;
      for (int cb = F.vcu; cb < 192; cb += F.G) { const int n0 = cb * 64 + 4 * cl;
          f32x4 acc[4];
#pragma unroll
          for (int b = 0; b < 4; ++b) acc[b] = (f32x4){0.f, 0.f, 0.f, 0.f};
#pragma unroll 4
          for (int it = 0; it < 64; ++it) { const int k = kg + 32 * it; const f32x4 w = *(const GAS f32x4*)(w_ada + (size_t)k * 12288 + n0);
#pragma unroll
              for (int b = 0; b < 4; ++b) acc[b] += sc[b * D + k] * w; }
#pragma unroll
          for (int b = 0; b < 4; ++b)
#pragma unroll
              for (int j = 0; j < 4; ++j) { float v = acc[b][j]; v += __shfl_xor(v, 16); v += __shfl_xor(v, 32); acc[b][j] = v; }
          if (F.lane < 16) {
#pragma unroll
              for (int b = 0; b < 4; ++b) *(LAS f32x4*)(red + (F.wave * 4 + b) * 64 + 4 * cl) = acc[b]; }
          LDS_WAIT(); __syncthreads();
          if (F.tid < 256) { const int b = F.tid >> 6, c = F.tid & 63; float s = b_ada[cb * 64 + c];
#pragma unroll
              for (int w = 0; w < 8; ++w) s += red[(w * 4 + b) * 64 + c];
              mod[b * 12288 + cb * 64 + c] = s; }
          __syncthreads(); } }
}

__device__ __forceinline__ void route_token(const Args& A, unsigned* ctl, int token);
template <int NT, bool ROUTE>
__device__ __forceinline__ void norm_rows_skinny(Frame& F, const Args& A, const float* xin, const float* gvec, const float* modsh, const float* modsc, bf16* Hout, const bf16* WT, float* outS, int ldS) {
    for (int task = F.gw; task < M / 16; task += F.NGW) {
        const int r0 = task * 16, b = r0 >> 12;
        for (int rr = 0; rr < 16; ++rr) {
            const int row = r0 + rr;
            const GAS f32x4* xr = (const GAS f32x4*)(xin + (size_t)row * D) + F.lane;
            f32x4 v[8]; float s = 0.f;
#pragma unroll
            for (int j = 0; j < 8; ++j) { v[j] = xr[64 * j]; s += (v[j].x * v[j].x + v[j].y * v[j].y) + (v[j].z * v[j].z + v[j].w * v[j].w); }
            const float r = rsqrtf(wave_sum(s) * (1.f / D) + EPS);
            GAS v2u* o8 = (GAS v2u*)(Hout + (size_t)row * D) + F.lane;
#pragma unroll
            for (int j = 0; j < 8; ++j) { const int k = 4 * F.lane + 256 * j;
                const f32x4 g4 = *(const f32x4*)(gvec + k), sc4 = *(const f32x4*)(modsc + b * 12288 + k), sh4 = *(const f32x4*)(modsh + b * 12288 + k);
                const f32x4 h = (v[j] * r) * g4 * (sc4 + 1.0f) + sh4;
                v2u w; w.x = pk2(h.x, h.y); w.y = pk2(h.z, h.w); o8[64 * j] = w; }
        }
        VM_WAIT();
        pg8::f32x4 acc[NT];
#pragma unroll
        for (int t = 0; t < NT; ++t) acc[t] = (pg8::f32x4){0.f, 0.f, 0.f, 0.f};
        const bf16* arow = Hout + (size_t)(r0 + (F.lane & 15)) * D + 8 * (F.lane >> 4);
        const bf16* brow = WT + (size_t)(F.lane & 15) * D + 8 * (F.lane >> 4);
#pragma unroll 4
        for (int s = 0; s < 64; ++s) { const bf16x8 a = *(const GAS bf16x8*)(arow + 32 * s);
#pragma unroll
            for (int t = 0; t < NT; ++t) { const bf16x8 bb = *(const GAS bf16x8*)(brow + (size_t)t * 16 * D + 32 * s);
                acc[t] = __builtin_amdgcn_mfma_f32_16x16x32_bf16(a, bb, acc[t], 0, 0, 0); } }
#pragma unroll
        for (int t = 0; t < NT; ++t)
#pragma unroll
            for (int rg = 0; rg < 4; ++rg) outS[(size_t)(r0 + 4 * (F.lane >> 4) + rg) * ldS + 16 * t + (F.lane & 15)] = acc[t][rg];
        if constexpr (ROUTE) { VM_WAIT(); if (F.lane < 16) route_token(A, F.ctl, r0 + F.lane); }
    }
}

__device__ __forceinline__ void p3_cumf(Frame& F, const Args& A) {
    const float* small = (const float*)(A.ws + WS_SMALL); float* cumf = (float*)(A.ws + WS_CUMF); const float* fbias = A.in[10];
    LAS float* red = (LAS float*)F.lds;
    for (int bh = F.vcu; bh < BATCH * NH; bh += F.G) { const int b = bh >> 3, h = bh & 7; const float fb = fbias[h];
        float v[8]; float run = 0.f;
#pragma unroll
        for (int i = 0; i < 8; ++i) { const int t = F.tid * 8 + i; run += logsigmoidf_(small[(size_t)(b * SEQ + t) * 32 + 16 + h] + fb); v[i] = run; }
        float inc = run;
#pragma unroll
        for (int o = 1; o < 64; o <<= 1) { const float t_ = __shfl_up(inc, o); if (F.lane >= o) inc += t_; }
        if (F.lane == 63) red[F.wave] = inc;
        LDS_WAIT(); __syncthreads();
        float base = inc - run;
        for (int w = 0; w < F.wave; ++w) base += red[w];
#pragma unroll
        for (int i = 0; i < 8; ++i) cumf[(size_t)bh * SEQ + F.tid * 8 + i] = base + v[i];
        __syncthreads();
    }
}

__device__ __forceinline__ void p4_attn_naive(Frame& F, const Args& A) {
    const bf16* QB = (const bf16*)(A.ws + WS_QKVB); const bf16* KB = QB + QKVB_STRIDE; const bf16* VB = KB + QKVB_STRIDE;
    const float* cumf = (const float*)(A.ws + WS_CUMF); bf16* MIX = (bf16*)(A.ws + WS_H);
    for (int row = F.gw; row < BATCH * NH * SEQ; row += F.NGW) { const int bh = row >> 12, t = row & 4095, b = bh >> 3, h = bh & 7;
        const unsigned qw = *(const unsigned*)(QB + (size_t)row * HD + 2 * F.lane);
        const float q0 = bflo(qw) * 0.08838834764831845f, q1 = bfhi(qw) * 0.08838834764831845f;
        const float Ft = cumf[(size_t)bh * SEQ + t];
        float m = -1e30f, l = 0.f, o0 = 0.f, o1 = 0.f;
        const bf16* kp = KB + (size_t)bh * SEQ * HD + 2 * F.lane; const bf16* vp = VB + (size_t)bh * SEQ * HD + 2 * F.lane; const float* fp = cumf + (size_t)bh * SEQ;
        for (int s = 0; s <= t; ++s) { const unsigned kw = *(const unsigned*)(kp + (size_t)s * HD), vw = *(const unsigned*)(vp + (size_t)s * HD);
            const float lg = wave_sum(q0 * bflo(kw) + q1 * bfhi(kw)) + (Ft - fp[s]);
            const float mn = fmaxf(m, lg), al = __expf(m - mn), p = __expf(lg - mn);
            l = l * al + p; o0 = o0 * al + p * bflo(vw); o1 = o1 * al + p * bfhi(vw); m = mn; }
        const float il = 1.f / l;
        *(unsigned*)(MIX + (size_t)(b * SEQ + t) * D + 1024 + h * HD + 2 * F.lane) = pk2(o0 * il, o1 * il);
    }
}

__device__ __forceinline__ void p4_dn_naive(Frame& F, const Args& A) {
    const bf16* QKVA = (const bf16*)(A.ws + WS_QKVA); const bf16* Z = (const bf16*)(A.ws + WS_Z); const float* small = (const float*)(A.ws + WS_SMALL);
    const float* conv_w = A.in[6]; const float* a_log = A.in[7]; const float* dt_bias = A.in[8]; const float* onorm = A.in[9]; bf16* MIX = (bf16*)(A.ws + WS_H);
    LAS float* raw = (LAS float*)F.lds; LAS float* red = raw + 384; LAS float* pdot = raw + 400; LAS float* po = raw + 400 + 512;
    const int j = F.tid & 127, qd = F.tid >> 7;
    for (int bh = F.vcu; bh < BATCH * NH; bh += F.G) { const int b = bh >> 3, h = bh & 7;
        float S[32];
#pragma unroll
        for (int i = 0; i < 32; ++i) S[i] = 0.f;
        const float Ah = __expf(a_log[h]), dtb = dt_bias[h];
        for (int t = 0; t < SEQ; ++t) { const size_t token = (size_t)b * SEQ + t;
            if (F.tid < 384) { const int tensor = F.tid >> 7, d = F.tid & 127, col = tensor * 1024 + h * HD + d; float y = 0.f;
#pragma unroll
                for (int jj = 0; jj < 4; ++jj) { const int tt = t - 3 + jj; if (tt >= 0) y += conv_w[jj * CONVCH + col] * bf2f(QKVA[(token - 3 + jj) * CONVCH + col]); }
                y = siluf(y); raw[F.tid] = y; const float ss = wave_sum(y * y); if (F.lane == 0) red[F.wave] = ss; }
            LDS_WAIT(); __syncthreads();
            const float qn = rsqrtf(red[0] + red[1] + EPS) * 0.08838834764831845f, kn = rsqrtf(red[2] + red[3] + EPS);
            const float av = small[token * 32 + h], bv = small[token * 32 + 8 + h];
            const float eg = __expf(-Ah * softplusf_(av + dtb)), beta = sigmoidf_(bv);
            float pd = 0.f;
#pragma unroll
            for (int i = 0; i < 32; ++i) { S[i] *= eg; pd += S[i] * (raw[128 + 32 * qd + i] * kn); }
            pdot[qd * 128 + j] = pd;
            LDS_WAIT(); __syncthreads();
            const float r = raw[256 + j] - ((pdot[j] + pdot[128 + j]) + (pdot[256 + j] + pdot[384 + j]));
            float pq = 0.f;
#pragma unroll
            for (int i = 0; i < 32; ++i) { S[i] += beta * (raw[128 + 32 * qd + i] * kn) * r; pq += S[i] * (raw[32 * qd + i] * qn); }
            po[qd * 128 + j] = pq;
            LDS_WAIT(); __syncthreads();
            float o = 0.f;
            if (F.tid < 128) { o = (po[j] + po[128 + j]) + (po[256 + j] + po[384 + j]); const float ss = wave_sum(o * o); if (F.lane == 0) red[8 + F.wave] = ss; }
            LDS_WAIT(); __syncthreads();
            if (F.tid < 128) { const float rn = rsqrtf((red[8] + red[9]) * (1.f / HD) + EPS);
                const float val = o * rn * onorm[j] * siluf(bf2f(Z[token * 1024 + h * HD + j]));
                MIX[token * D + h * HD + j] = (bf16)f2bf(val); }
            __syncthreads();
        }
    }
}

__device__ __forceinline__ void route_token(const Args& A, unsigned* ctl, int token) {
    const float* rl = (const float*)(A.ws + WS_RL) + (size_t)token * 48; const float* b_rg = A.in[14]; const float* b_re = A.in[16];
    float gl[4]; int gi = 0;
#pragma unroll
    for (int g = 0; g < 4; ++g) { gl[g] = rl[g] + b_rg[g]; }
#pragma unroll
    for (int g = 1; g < 4; ++g) if (gl[g] > gl[gi]) gi = g;
    float gs = 0.f;
#pragma unroll
    for (int g = 0; g < 4; ++g) gs += __expf(gl[g] - gl[gi]);
    const float pg = 1.f / gs;
    float el[8];
#pragma unroll
    for (int e = 0; e < 8; ++e) el[e] = rl[4 + gi * 8 + e] + b_re[gi * 8 + e];
    int i0 = 0;
#pragma unroll
    for (int e = 1; e < 8; ++e) if (el[e] > el[i0]) i0 = e;
    int i1 = (i0 == 0) ? 1 : 0;
#pragma unroll
    for (int e = 0; e < 8; ++e) if (e != i0 && el[e] > el[i1]) i1 = e;
    const float e1 = __expf(el[i1] - el[i0]); const float w0 = pg / (1.f + e1), w1 = pg * e1 / (1.f + e1);
    int* toke = (int*)(A.ws + WS_ROUTE + RT_TOKE); float* tokw = (float*)(A.ws + WS_ROUTE + RT_TOKW); int* tokr = (int*)(A.ws + WS_ROUTE + RT_TOKR);
    const int ge0 = gi * 8 + i0, ge1 = gi * 8 + i1;
    toke[token * 2] = ge0; toke[token * 2 + 1] = ge1; tokw[token * 2] = w0; tokw[token * 2 + 1] = w1;
    tokr[token * 2] = (int)atomicAdd(ctl + CW_CNT + 64 * ge0, 1u); tokr[token * 2 + 1] = (int)atomicAdd(ctl + CW_CNT + 64 * ge1, 1u);
}
__device__ __forceinline__ void expert_offsets(Frame& F, LAS int* off) {
    if (F.tid == 0) { int run = 0; for (int e = 0; e < NE; ++e) { off[e] = run; const int c = (int)__hip_atomic_load(F.ctl + CW_CNT + 64 * e, RLX_AGENT); off[NE + 1 + e] = c; run += (c + 255) & ~255; } off[NE] = run; }
    LDS_WAIT(); __syncthreads();
}
__device__ __forceinline__ void p8_slots(Frame& F, const Args& A) {
    LAS int* off = (LAS int*)F.lds; expert_offsets(F, off);
    const int* toke = (const int*)(A.ws + WS_ROUTE + RT_TOKE); const float* tokw = (const float*)(A.ws + WS_ROUTE + RT_TOKW); int* tokr = (int*)(A.ws + WS_ROUTE + RT_TOKR);
    int* list = (int*)(A.ws + WS_ROUTE + RT_LIST); float* slotw = (float*)(A.ws + WS_ROUTE + RT_SLOTW);
    const int gt = F.vcu * NTHR + F.tid, NT_ = F.G * NTHR;
    for (int i = gt; i < M * 2; i += NT_) { const int e = toke[i]; const int slot = off[e] + tokr[i]; tokr[i] = slot; list[slot] = i >> 1; slotw[slot] = tokw[i]; }
    const int total = off[NE];
    for (int s = gt; s < total; s += NT_) { int e = 0;
        for (int k = 1; k < NE; ++k) if (s >= off[k]) e = k;
        if (s - off[e] >= off[NE + 1 + e]) { list[s] = -1; slotw[s] = 0.f; } }
    __syncthreads();
}
__device__ __forceinline__ void p9_moe_naive(Frame& F, const Args& A) {
    LAS int* off = (LAS int*)(F.lds + 98304); expert_offsets(F, off);
    LAS float* hrow = (LAS float*)F.lds;
    LAS float* hid = (LAS float*)(F.lds + 65536);
    const bf16* H2 = (const bf16*)(A.ws + WS_H); const int* list = (const int*)(A.ws + WS_ROUTE + RT_LIST); const float* slotw = (const float*)(A.ws + WS_ROUTE + RT_SLOTW);
    bf16* Y = (bf16*)(A.ws + WS_Y); const float* w1 = A.in[17]; const float* w3 = A.in[18]; const float* w2 = A.in[19];
    const int total = off[NE];
    for (int g8 = F.vcu; g8 * 8 < total; g8 += F.G) { const int s0 = g8 * 8; int e = 0;
        for (int k = 1; k < NE; ++k) if (s0 >= off[k]) e = k;
#pragma unroll
        for (int i = 0; i < 8; ++i) { const int tok = list[s0 + i]; f32x4 hv = (f32x4){0.f, 0.f, 0.f, 0.f};
            if (tok >= 0) { const v2u w = *(const v2u*)(H2 + (size_t)tok * D + 4 * F.tid); hv = (f32x4){bflo(w.x), bfhi(w.x), bflo(w.y), bfhi(w.y)}; }
            *(LAS f32x4*)(hrow + i * 2048 + 4 * F.tid) = hv; }
        LDS_WAIT(); __syncthreads();
        { float a[8], bq[8];
#pragma unroll
          for (int i = 0; i < 8; ++i) { a[i] = 0.f; bq[i] = 0.f; }
          const float* p1 = w1 + (size_t)e * D * DE + F.tid; const float* p3 = w3 + (size_t)e * D * DE + F.tid;
#pragma unroll 2
          for (int k = 0; k < D; k += 4) { float u1[4], u3[4];
#pragma unroll
              for (int kk = 0; kk < 4; ++kk) { u1[kk] = p1[(size_t)(k + kk) * DE]; u3[kk] = p3[(size_t)(k + kk) * DE]; }
#pragma unroll
              for (int i = 0; i < 8; ++i) { const f32x4 hv = *(const LAS f32x4*)(hrow + i * 2048 + k);
                  a[i] += hv.x * u1[0] + hv.y * u1[1] + hv.z * u1[2] + hv.w * u1[3]; bq[i] += hv.x * u3[0] + hv.y * u3[1] + hv.z * u3[2] + hv.w * u3[3]; } }
#pragma unroll
          for (int i = 0; i < 8; ++i) hid[i * 512 + F.tid] = siluf(a[i]) * bq[i] * slotw[s0 + i]; }
        LDS_WAIT(); __syncthreads();
        { f32x4 y[8];
#pragma unroll
          for (int i = 0; i < 8; ++i) y[i] = (f32x4){0.f, 0.f, 0.f, 0.f};
          const float* p2 = w2 + (size_t)e * DE * D + 4 * F.tid;
#pragma unroll 4
          for (int f = 0; f < DE; ++f) { const f32x4 wv = *(const GAS f32x4*)(p2 + (size_t)f * D);
#pragma unroll
              for (int i = 0; i < 8; ++i) y[i] += hid[i * 512 + f] * wv; }
#pragma unroll
          for (int i = 0; i < 8; ++i) { v2u w; w.x = pk2(y[i].x, y[i].y); w.y = pk2(y[i].z, y[i].w); *(v2u*)(Y + (size_t)(s0 + i) * D + 4 * F.tid) = w; } }
        __syncthreads();
    }
}
__device__ __forceinline__ void p11_final(Frame& F, const Args& A) {
    const float* mod = (const float*)(F.ctl + CW_MOD); const bf16* Y = (const bf16*)(A.ws + WS_Y); const int* tokr = (const int*)(A.ws + WS_ROUTE + RT_TOKR); const float* fg = A.in[20];
    for (int row = F.gw; row < M; row += F.NGW) { const int b = row >> 12; const int s0 = tokr[row * 2], s1 = tokr[row * 2 + 1];
        GAS f32x4* xr = (GAS f32x4*)(A.out + (size_t)row * D) + F.lane;
        const GAS v2u* y0 = (const GAS v2u*)(Y + (size_t)s0 * D) + F.lane; const GAS v2u* y1 = (const GAS v2u*)(Y + (size_t)s1 * D) + F.lane;
        f32x4 v[8]; float s = 0.f;
#pragma unroll
        for (int j = 0; j < 8; ++j) { const int k = 4 * F.lane + 256 * j; const f32x4 g2 = *(const f32x4*)(mod + b * 12288 + 5 * D + k);
            const v2u a = y0[64 * j], c = y1[64 * j];
            const f32x4 ys = (f32x4){bflo(a.x) + bflo(c.x), bfhi(a.x) + bfhi(c.x), bflo(a.y) + bflo(c.y), bfhi(a.y) + bfhi(c.y)};
            v[j] = xr[64 * j] + g2 * ys; s += (v[j].x * v[j].x + v[j].y * v[j].y) + (v[j].z * v[j].z + v[j].w * v[j].w); }
        const float r = rsqrtf(wave_sum(s) * (1.f / D) + EPS);
#pragma unroll
        for (int j = 0; j < 8; ++j) { const int k = 4 * F.lane + 256 * j; xr[64 * j] = (v[j] * r) * *(const f32x4*)(fg + k); }
    }
}

#define IN(k) (lo <= (k) && (k) < hi)
__global__ void __launch_bounds__(NTHR, 2) fwd(Args args) {
    extern __shared__ __attribute__((aligned(16))) unsigned char lds[];
    Frame F;
    F.lds = (LAS unsigned char*)lds; F.MISC = (volatile LAS unsigned*)(F.lds + MISC_OFF);
    F.tid = threadIdx.x; F.lane = F.tid & 63; F.wave = __builtin_amdgcn_readfirstlane(F.tid >> 6);
    F.G = gridDim.x; { const int bx = blockIdx.x; F.vcu = (F.G % 8 == 0) ? (bx % 8) * (F.G / 8) + bx / 8 : bx; }
    F.gw = F.vcu * NWAVES + F.wave; F.NGW = F.G * NWAVES;
    F.ctl = (unsigned*)(args.ws + WS_CTL);
    for (int u = F.tid; u < (LDS_BYTES - LDSCTL_OFF) / 4; u += NTHR) ((LAS unsigned*)(F.lds + LDSCTL_OFF))[u] = 0u;
    __syncthreads();
    const int lo = args.ph_lo, hi = args.ph_hi;
    XcdBarrier bar; bar.bar = F.ctl + CW_BAR; bar.x = 0; bar.st = nullptr;
    if (hi - lo > 1) bar = xcd_barrier_post(F.ctl + CW_BAR, F.MISC + 8);
#define SEAM(k) do { if (IN(k) && hi > (k) + 1) xcd_barrier(bar); } while (0)
    unsigned char* ws = args.ws;
    const float* mod = (const float*)(F.ctl + CW_MOD);

    if (IN(0)) { p0_prologue(F, args); SEAM(0); }
    if (IN(1)) { norm_rows_skinny<2, false>(F, args, args.in[0], args.in[4], mod, mod + D, (bf16*)(ws + WS_H), (const bf16*)(ws + WS_WST), (float*)(ws + WS_SMALL), 32); SEAM(1); }
    if (IN(2)) {
        pg8::Gemm g{(const pg8::bf16_t*)(ws + WS_H), (const pg8::bf16_t*)(ws + WS_WINT), M, NBIG, D}; pg8::StaticOrder S; S.init(M, NBIG, F.G, (int)blockIdx.x);
        EpiProj E{(bf16*)(ws + WS_QKVA), (bf16*)(ws + WS_Z), (bf16*)(ws + WS_QKVB)};
        pg8::gemm_phase<EpiProj, pg8::StaticOrder, true, true>(F.lds, g, S, E);
        SEAM(2); }
    if (IN(3)) { p3_cumf(F, args); SEAM(3); }
    if (IN(4)) { p4_dn_naive(F, args); p4_attn_naive(F, args); SEAM(4); }
    if (IN(5)) {
        pg8::Gemm g{(const pg8::bf16_t*)(ws + WS_H), (const pg8::bf16_t*)(ws + WS_WOUTT), M, D, D}; pg8::StaticOrder S; S.init(M, D, F.G, (int)blockIdx.x);
        EpiMix E{args.in[0], mod, args.out};
        pg8::gemm_phase<EpiMix, pg8::StaticOrder, true, true>(F.lds, g, S, E);
        SEAM(5); }
    if (IN(6)) { norm_rows_skinny<3, true>(F, args, args.out, args.in[12], mod + 3 * D, mod + 4 * D, (bf16*)(ws + WS_H), (const bf16*)(ws + WS_WRT), (float*)(ws + WS_RL), 48); SEAM(6); }
    if (IN(7)) { p8_slots(F, args); SEAM(7); }
    if (IN(8)) { p9_moe_naive(F, args); SEAM(8); }
    if (IN(9)) { p11_final(F, args); }
}
constexpr int NPHASE = 10;

extern "C" void kernel_launch(void* const* d_in, const int* in_sizes, int n_in, void* d_out, int out_size, void* d_ws, size_t ws_size, hipStream_t stream) {
    static int grid = 0;
    if (grid == 0) {
        if (n_in != 21 || out_size != M * D || ws_size < WS_END) { fprintf(stderr, "kernel_launch: unexpected shapes (n_in %d out %d ws %zu)\n", n_in, out_size, ws_size); grid = -1; return; }
        int dev = 0, cus = 0;
        if (hipGetDevice(&dev) != hipSuccess || hipDeviceGetAttribute(&cus, hipDeviceAttributeMultiprocessorCount, dev) != hipSuccess) { grid = -1; return; }
        if (hipFuncSetAttribute((const void*)fwd, hipFuncAttributeMaxDynamicSharedMemorySize, LDS_BYTES) != hipSuccess) { fprintf(stderr, "kernel_launch: hipFuncSetAttribute failed\n"); grid = -1; return; }
        int per_cu = 0; (void)hipOccupancyMaxActiveBlocksPerMultiprocessor(&per_cu, (const void*)fwd, NTHR, LDS_BYTES); (void)hipGetLastError();
        grid = cus;
    }
    if (grid < 0) return;
    if (hipMemsetAsync((char*)d_ws + WS_CTL, 0, CTL_ZERO_BYTES, stream) != hipSuccess) return;
    Args a{};
    for (int i = 0; i < 21; ++i) a.in[i] = (const float*)d_in[i];
    a.out = (float*)d_out; a.ws = (unsigned char*)d_ws;
#ifndef ONE_LAUNCH
    for (int p = 0; p < NPHASE; ++p) { a.ph_lo = p; a.ph_hi = p + 1; hipLaunchKernelGGL(fwd, dim3(grid), dim3(NTHR), LDS_BYTES, stream, a); }
#else
    a.ph_lo = 0; a.ph_hi = NPHASE; hipLaunchKernelGGL(fwd, dim3(grid), dim3(NTHR), LDS_BYTES, stream, a);
#endif
}
```

```cpp
#include <hip/hip_runtime.h>
#include <cstdio>
#include <cstdint>
namespace pg8 {
#define PG8_LAS __attribute__((address_space(3)))
typedef unsigned short bf16_t;
typedef short bf16x8 __attribute__((ext_vector_type(8)));
typedef float f32x4 __attribute__((ext_vector_type(4)));
typedef unsigned u32x4 __attribute__((ext_vector_type(4)));
constexpr int BM = 256, BK = 64, HALF = 128, HTB = HALF * BK * 2  , STAGE_BYTES = 8 * HTB, NXCD = 8, WGM = 8;

__host__ __device__ __forceinline__ int lds_byte(int r, int c) { const int st = (r >> 4) * 2 + (c >> 5), rr = r & 15, cc = c & 31, ob = rr * 64 + cc * 2; return st * 1024 + (ob ^ (((ob >> 9) & 1) << 5)); }
__host__ __device__ __forceinline__ void stage_rc(int b, int& R, int& C) { const int st = b / 1024, sb = b % 1024, swz = sb ^ (((sb >> 9) & 1) << 5); R = (st >> 1) * 16 + swz / 64; C = (st & 1) * 32 + (swz % 64) / 2; }
__host__ __device__ __forceinline__ int perm32(int rho) { const int n = rho >> 4, i = rho & 15; return 8 * (i >> 2) + 4 * n + (i & 3); }

struct Unit { int pm, pn; };
struct Gemm { const bf16_t* A; const bf16_t* Bt; int M, N, K; };

struct StaticOrder {
    int nM, nN, nwg, G, c;
    __host__ __device__ void init(int M, int N, int G_, int c_) { nM = M / BM; nN = N / BM; nwg = nM * nN; G = G_; c = c_; }
    __host__ __device__ bool next(int i, Unit& u) const {
        const long L = (long)i * G + c; if (L >= nwg) return false;
        int wgid = (int)L; { const int q = nwg / NXCD, r = nwg % NXCD, xcd = wgid % NXCD, off = wgid / NXCD; wgid = (xcd < r ? xcd * (q + 1) : r * (q + 1) + (xcd - r) * q) + off; }
        const int nig = WGM * nN, gid = wgid / nig, fm = gid * WGM, gsz = (nM - fm) < WGM ? (nM - fm) : WGM;
        u.pm = fm + ((wgid % nig) % gsz); u.pn = (wgid % nig) / gsz; return true;
    }
    __device__ __forceinline__ void a_ready(const Unit&) const {}
    __device__ __forceinline__ void done(const Unit&) const {}
};
__device__ __forceinline__ unsigned cvt_pk_bf16(float lo, float hi) { unsigned r; asm volatile("v_cvt_pk_bf16_f32 %0, %1, %2" : "=v"(r) : "v"(lo), "v"(hi)); return r; }
typedef unsigned u32x2 __attribute__((ext_vector_type(2)));
template <class Epi, class Sched, bool ALIGN_EPI = false, bool SP2 = false>
__device__ __forceinline__ void gemm_phase(PG8_LAS unsigned char* lds, const Gemm g, const Sched& S, const Epi& E) {
    const int tid = threadIdx.x, wid = __builtin_amdgcn_readfirstlane(tid >> 6), lane = tid & 63, wr = wid >> 2, wc = wid & 3, fr = lane & 15, fq = lane >> 4;
    const int K = g.K, nt = K / BK;
    unsigned voffA[2], voffB[2];
#pragma unroll
    for (int i = 0; i < 2; ++i) { int R, C; stage_rc(tid * 16 + i * 8192, R, C); const int Rb = Epi::PERM ? ((R & ~31) + perm32(R & 31)) : R;
        voffA[i] = (unsigned)(R * K + C) * 2u; voffB[i] = (unsigned)(Rb * K + C) * 2u; }
    const size_t kstep = (size_t)(BK * 2);
    const size_t hstep = (size_t)HALF * K * 2;
    const size_t tstep = 2 * hstep;
    const unsigned ldsw = (unsigned)wid * 1024u;
    const int aoff = lds_byte(wr * 64 + fr, fq * 8), boff = lds_byte(wc * 32 + fr, fq * 8);
#define PG8_SA(b, h) (((b) * 2 + (h)) * HTB)
#define PG8_SB(b, h) ((4 + (b) * 2 + (h)) * HTB)
#define PG8_STAGE(bufoff, gbase, voff) do { _Pragma("unroll") for (int _i = 0; _i < 2; ++_i) \
        __builtin_amdgcn_global_load_lds((const unsigned*)((const char*)(gbase) + (voff)[_i]), (PG8_LAS unsigned*)(lds + (bufoff) + ldsw + _i * 8192), 16, 0, 0); } while (0)
#define PG8_LDA(dst, b, h) do { _Pragma("unroll") for (int m = 0; m < 4; ++m) _Pragma("unroll") for (int k = 0; k < 2; ++k) dst[m][k] = *(const PG8_LAS bf16x8*)(lds + PG8_SA(b, h) + aoff + m * 2048 + k * 1024); } while (0)
#define PG8_LDB(dst, b, h) do { _Pragma("unroll") for (int n = 0; n < 2; ++n) _Pragma("unroll") for (int k = 0; k < 2; ++k) dst[n][k] = *(const PG8_LAS bf16x8*)(lds + PG8_SB(b, h) + boff + n * 2048 + k * 1024); } while (0)
#define PG8_MMA(ai, bj, At, Bt) do { __builtin_amdgcn_s_setprio(1); _Pragma("unroll") for (int m = 0; m < 4; ++m) _Pragma("unroll") for (int n = 0; n < 2; ++n) _Pragma("unroll") for (int k = 0; k < 2; ++k) \
        acc[ai][bj][m][n] = __builtin_amdgcn_mfma_f32_16x16x32_bf16(Bt[n][k], At[m][k], acc[ai][bj][m][n], 0, 0, 0); __builtin_amdgcn_s_setprio(0); } while (0)
#define PG8_WAIT_V(n) asm volatile("s_waitcnt vmcnt(" #n ")" ::: "memory")
#define PG8_WAIT_L(n) asm volatile("s_waitcnt lgkmcnt(" #n ")" ::: "memory")
#define PG8_BAR __builtin_amdgcn_s_barrier()
#define PG8_SCHED __builtin_amdgcn_sched_barrier(0)
    Unit cur, nxt; int ui = 0;
    if (!S.next(0, cur)) return;
    f32x4 acc[2][2][4][2];
#pragma unroll
    for (int a = 0; a < 2; ++a)
#pragma unroll
        for (int b = 0; b < 2; ++b)
#pragma unroll
            for (int m = 0; m < 4; ++m)
#pragma unroll
                for (int n = 0; n < 2; ++n) acc[a][b][m][n] = (f32x4){0.f, 0.f, 0.f, 0.f};
    bf16x8 At[4][2], B0[2][2], B1[2][2];
    const char* cA = (const char*)g.A + (size_t)cur.pm * tstep; const char* cB = (const char*)g.Bt + (size_t)cur.pn * tstep;
    S.a_ready(cur);
    if constexpr (SP2) {
        PG8_STAGE(PG8_SB(0, 0), cB, voffB); PG8_STAGE(PG8_SB(0, 1), cB + hstep, voffB); PG8_STAGE(PG8_SA(0, 0), cA, voffA); PG8_STAGE(PG8_SA(0, 1), cA + hstep, voffA);
        if (wr == 1) PG8_BAR;
        PG8_WAIT_V(2); PG8_BAR;
        PG8_STAGE(PG8_SB(1, 0), cB + kstep, voffB); PG8_STAGE(PG8_SA(1, 0), cA + kstep, voffA); PG8_STAGE(PG8_SB(1, 1), cB + hstep + kstep, voffB);
        PG8_WAIT_V(6); PG8_BAR;
    } else {
        PG8_STAGE(PG8_SB(0, 0), cB, voffB); PG8_STAGE(PG8_SA(0, 0), cA, voffA); PG8_STAGE(PG8_SB(0, 1), cB + hstep, voffB); PG8_STAGE(PG8_SA(0, 1), cA + hstep, voffA);
        if (wr == 1) PG8_BAR;
        PG8_WAIT_V(4); PG8_BAR;
        PG8_STAGE(PG8_SB(1, 0), cB + kstep, voffB); PG8_STAGE(PG8_SA(1, 0), cA + kstep, voffA); PG8_STAGE(PG8_SB(1, 1), cB + hstep + kstep, voffB);
        PG8_WAIT_V(6); PG8_BAR;
    }
    for (;;) {
        const bool has_next = S.next(ui + 1, nxt);
        const char* nA = has_next ? (const char*)g.A + (size_t)nxt.pm * tstep : cA; const char* nB = has_next ? (const char*)g.Bt + (size_t)nxt.pn * tstep : cB;
        for (int t = 0; t < nt; t += 2) {
            const bool last = (t == nt - 2);
            const char* a1 = cA + (size_t)(t + 1) * kstep;
            const char* a2 = last ? nA : cA + (size_t)(t + 2) * kstep; const char* b2 = last ? nB : cB + (size_t)(t + 2) * kstep;
            const char* a3 = a2 + kstep; const char* b3 = b2 + kstep;
            if (last && has_next) S.a_ready(nxt);
            if constexpr (SP2) {
            PG8_LDB(B0, 0, 0); PG8_LDB(B1, 0, 1); PG8_SCHED; PG8_LDA(At, 0, 0); PG8_STAGE(PG8_SA(1, 1), a1 + hstep, voffA);
            PG8_WAIT_V(8); PG8_WAIT_L(0); PG8_BAR; PG8_MMA(0, 0, At, B0); PG8_MMA(0, 1, At, B1); PG8_BAR; PG8_SCHED;
            PG8_LDA(At, 0, 1); PG8_STAGE(PG8_SB(0, 0), b2, voffB); PG8_STAGE(PG8_SB(0, 1), b2 + hstep, voffB); PG8_STAGE(PG8_SA(0, 0), a2, voffA);
            PG8_WAIT_V(8); PG8_WAIT_L(0); PG8_BAR; PG8_MMA(1, 0, At, B0); PG8_MMA(1, 1, At, B1); PG8_BAR; PG8_SCHED;
            PG8_LDB(B0, 1, 0); PG8_LDB(B1, 1, 1); PG8_SCHED; PG8_LDA(At, 1, 0); PG8_STAGE(PG8_SA(0, 1), a2 + hstep, voffA);
            PG8_WAIT_V(8); PG8_WAIT_L(0); PG8_BAR; PG8_MMA(0, 0, At, B0); PG8_MMA(0, 1, At, B1); PG8_BAR; PG8_SCHED;
            PG8_LDA(At, 1, 1); PG8_STAGE(PG8_SB(1, 0), b3, voffB); PG8_STAGE(PG8_SB(1, 1), b3 + hstep, voffB); PG8_STAGE(PG8_SA(1, 0), a3, voffA);
            PG8_WAIT_V(8); PG8_WAIT_L(0); PG8_BAR; PG8_MMA(1, 0, At, B0); PG8_MMA(1, 1, At, B1); PG8_BAR; PG8_SCHED;
            } else {
            PG8_LDB(B0, 0, 0); PG8_SCHED; PG8_LDA(At, 0, 0); PG8_STAGE(PG8_SA(1, 1), a1 + hstep, voffA);
            PG8_WAIT_L(8); PG8_BAR; PG8_WAIT_L(0); PG8_MMA(0, 0, At, B0); PG8_BAR; PG8_SCHED;
            PG8_LDB(B1, 0, 1); PG8_STAGE(PG8_SB(0, 0), b2, voffB);
            PG8_BAR; PG8_WAIT_L(0); PG8_MMA(0, 1, At, B1); PG8_BAR;
            PG8_LDA(At, 0, 1); PG8_STAGE(PG8_SA(0, 0), a2, voffA);
            PG8_BAR; PG8_WAIT_L(0); PG8_MMA(1, 0, At, B0); PG8_BAR; PG8_SCHED;
            PG8_STAGE(PG8_SB(0, 1), b2 + hstep, voffB);
            PG8_WAIT_V(6); PG8_BAR; PG8_MMA(1, 1, At, B1); PG8_BAR;
            PG8_LDB(B0, 1, 0); PG8_SCHED; PG8_LDA(At, 1, 0); PG8_STAGE(PG8_SA(0, 1), a2 + hstep, voffA);
            PG8_WAIT_L(8); PG8_BAR; PG8_WAIT_L(0); PG8_MMA(0, 0, At, B0); PG8_BAR; PG8_SCHED;
            PG8_LDB(B1, 1, 1); PG8_STAGE(PG8_SB(1, 0), b3, voffB);
            PG8_BAR; PG8_WAIT_L(0); PG8_MMA(0, 1, At, B1); PG8_BAR;
            PG8_LDA(At, 1, 1); PG8_STAGE(PG8_SA(1, 0), a3, voffA);
            PG8_BAR; PG8_WAIT_L(0); PG8_MMA(1, 0, At, B0); PG8_BAR; PG8_SCHED;
            PG8_STAGE(PG8_SB(1, 1), b3 + hstep, voffB);
            PG8_WAIT_V(6); PG8_BAR; PG8_MMA(1, 1, At, B1); PG8_BAR;
            }
        }
        if constexpr (ALIGN_EPI) { if (wr == 0) PG8_BAR; }
        if constexpr (!Epi::AFTER_DRAIN) { E(acc, cur, wr, wc, fr, fq); S.done(cur); }
        if (!has_next) break;
#pragma unroll
        for (int a = 0; a < 2; ++a)
#pragma unroll
            for (int b = 0; b < 2; ++b)
#pragma unroll
                for (int m = 0; m < 4; ++m)
#pragma unroll
                    for (int n = 0; n < 2; ++n) acc[a][b][m][n] = (f32x4){0.f, 0.f, 0.f, 0.f};
        cur = nxt; cA = nA; cB = nB; ++ui;
        if constexpr (ALIGN_EPI) { if (wr == 1) PG8_BAR; }
    }
    PG8_WAIT_V(0);
    if constexpr (!ALIGN_EPI) { if (wr == 0) PG8_BAR; }
    PG8_BAR;
    if constexpr (Epi::AFTER_DRAIN) { E.fused(acc, cur, wr, wc, fr, fq, lds, wid, lane); S.done(cur); }
#undef PG8_SA
#undef PG8_SB
#undef PG8_STAGE
#undef PG8_LDA
#undef PG8_LDB
#undef PG8_MMA
#undef PG8_WAIT_V
#undef PG8_WAIT_L
#undef PG8_BAR
#undef PG8_SCHED
}
template <class Epi, class Sched, bool ALIGN_EPI = false, bool SP2 = false>
__device__ __forceinline__ void gemm_phase_g(PG8_LAS unsigned char* lds, const Gemm g, const Sched& S, const Epi& E, const int* __restrict__ rowlist) {
    const int tid = threadIdx.x, wid = __builtin_amdgcn_readfirstlane(tid >> 6), lane = tid & 63, wr = wid >> 2, wc = wid & 3, fr = lane & 15, fq = lane >> 4;
    const int K = g.K, nt = K / BK;
    unsigned voffB[2]; int RA[2], CA[2];
#pragma unroll
    for (int i = 0; i < 2; ++i) { int R, C; stage_rc(tid * 16 + i * 8192, R, C); const int Rb = Epi::PERM ? ((R & ~31) + perm32(R & 31)) : R;
        RA[i] = R; CA[i] = C * 2; voffB[i] = (unsigned)(Rb * K + C) * 2u; }
    unsigned va[2][2], vn[2][2], vs[2][2];
#define PG8_GATHER(dst, u) do { _Pragma("unroll") for (int h_ = 0; h_ < 2; ++h_) _Pragma("unroll") for (int i_ = 0; i_ < 2; ++i_) { int tk_ = rowlist[(u).pm * BM + h_ * HALF + RA[i_]]; tk_ = tk_ < 0 ? 0 : tk_; dst[h_][i_] = (unsigned)tk_ * (unsigned)(K * 2) + (unsigned)CA[i_]; } } while (0)
    const size_t kstep = (size_t)(BK * 2);
    const size_t hstep = (size_t)HALF * K * 2;
    const size_t tstep = 2 * hstep;
    const unsigned ldsw = (unsigned)wid * 1024u;
    const int aoff = lds_byte(wr * 64 + fr, fq * 8), boff = lds_byte(wc * 32 + fr, fq * 8);
#define PG8_SA(b, h) (((b) * 2 + (h)) * HTB)
#define PG8_SB(b, h) ((4 + (b) * 2 + (h)) * HTB)
#define PG8_STAGE(bufoff, gbase, voff) do { _Pragma("unroll") for (int _i = 0; _i < 2; ++_i) \
        __builtin_amdgcn_global_load_lds((const unsigned*)((const char*)(gbase) + (voff)[_i]), (PG8_LAS unsigned*)(lds + (bufoff) + ldsw + _i * 8192), 16, 0, 0); } while (0)
#define PG8_STAGE_A(bufoff, gbase, OFFS, hh) do { _Pragma("unroll") for (int _i = 0; _i < 2; ++_i) \
        __builtin_amdgcn_global_load_lds((const unsigned*)((const char*)(gbase) + (OFFS)[hh][_i]), (PG8_LAS unsigned*)(lds + (bufoff) + ldsw + _i * 8192), 16, 0, 0); } while (0)
#define PG8_LDA(dst, b, h) do { _Pragma("unroll") for (int m = 0; m < 4; ++m) _Pragma("unroll") for (int k = 0; k < 2; ++k) dst[m][k] = *(const PG8_LAS bf16x8*)(lds + PG8_SA(b, h) + aoff + m * 2048 + k * 1024); } while (0)
#define PG8_LDB(dst, b, h) do { _Pragma("unroll") for (int n = 0; n < 2; ++n) _Pragma("unroll") for (int k = 0; k < 2; ++k) dst[n][k] = *(const PG8_LAS bf16x8*)(lds + PG8_SB(b, h) + boff + n * 2048 + k * 1024); } while (0)
#define PG8_MMA(ai, bj, At, Bt) do { __builtin_amdgcn_s_setprio(1); _Pragma("unroll") for (int m = 0; m < 4; ++m) _Pragma("unroll") for (int n = 0; n < 2; ++n) _Pragma("unroll") for (int k = 0; k < 2; ++k) \
        acc[ai][bj][m][n] = __builtin_amdgcn_mfma_f32_16x16x32_bf16(Bt[n][k], At[m][k], acc[ai][bj][m][n], 0, 0, 0); __builtin_amdgcn_s_setprio(0); } while (0)
#define PG8_WAIT_V(n) asm volatile("s_waitcnt vmcnt(" #n ")" ::: "memory")
#define PG8_WAIT_L(n) asm volatile("s_waitcnt lgkmcnt(" #n ")" ::: "memory")
#define PG8_BAR __builtin_amdgcn_s_barrier()
#define PG8_SCHED __builtin_amdgcn_sched_barrier(0)
    Unit cur, nxt; int ui = 0;
    if (!S.next(0, cur)) return;
    f32x4 acc[2][2][4][2];
#pragma unroll
    for (int a = 0; a < 2; ++a)
#pragma unroll
        for (int b = 0; b < 2; ++b)
#pragma unroll
            for (int m = 0; m < 4; ++m)
#pragma unroll
                for (int n = 0; n < 2; ++n) acc[a][b][m][n] = (f32x4){0.f, 0.f, 0.f, 0.f};
    bf16x8 At[4][2], B0[2][2], B1[2][2];
    const char* cA = (const char*)g.A; const char* cB = (const char*)g.Bt + (size_t)cur.pn * tstep;
    S.a_ready(cur);
    PG8_GATHER(va, cur);
    if constexpr (SP2) {
        PG8_STAGE(PG8_SB(0, 0), cB, voffB); PG8_STAGE(PG8_SB(0, 1), cB + hstep, voffB); PG8_STAGE_A(PG8_SA(0, 0), cA, va, 0); PG8_STAGE_A(PG8_SA(0, 1), cA, va, 1);
        if (wr == 1) PG8_BAR;
        PG8_WAIT_V(2); PG8_BAR;
        PG8_STAGE(PG8_SB(1, 0), cB + kstep, voffB); PG8_STAGE_A(PG8_SA(1, 0), cA + kstep, va, 0); PG8_STAGE(PG8_SB(1, 1), cB + hstep + kstep, voffB);
        PG8_WAIT_V(6); PG8_BAR;
    } else {
        PG8_STAGE(PG8_SB(0, 0), cB, voffB); PG8_STAGE_A(PG8_SA(0, 0), cA, va, 0); PG8_STAGE(PG8_SB(0, 1), cB + hstep, voffB); PG8_STAGE_A(PG8_SA(0, 1), cA, va, 1);
        if (wr == 1) PG8_BAR;
        PG8_WAIT_V(4); PG8_BAR;
        PG8_STAGE(PG8_SB(1, 0), cB + kstep, voffB); PG8_STAGE_A(PG8_SA(1, 0), cA + kstep, va, 0); PG8_STAGE(PG8_SB(1, 1), cB + hstep + kstep, voffB);
        PG8_WAIT_V(6); PG8_BAR;
    }
    for (;;) {
        const bool has_next = S.next(ui + 1, nxt);
        const char* nA = cA; const char* nB = has_next ? (const char*)g.Bt + (size_t)nxt.pn * tstep : cB;
        if (has_next) { PG8_GATHER(vn, nxt); } else { _Pragma("unroll") for (int h_ = 0; h_ < 2; ++h_) _Pragma("unroll") for (int i_ = 0; i_ < 2; ++i_) vn[h_][i_] = va[h_][i_]; }
        for (int t = 0; t < nt; t += 2) {
            const bool last = (t == nt - 2);
            const char* a1 = cA + (size_t)(t + 1) * kstep;
            const char* a2 = last ? nA : cA + (size_t)(t + 2) * kstep; const char* b2 = last ? nB : cB + (size_t)(t + 2) * kstep;
            const char* a3 = a2 + kstep; const char* b3 = b2 + kstep;
            if (last && has_next) S.a_ready(nxt);
#pragma unroll
            for (int h_ = 0; h_ < 2; ++h_)
#pragma unroll
                for (int i_ = 0; i_ < 2; ++i_) vs[h_][i_] = last ? vn[h_][i_] : va[h_][i_];
            if constexpr (SP2) {
            PG8_LDB(B0, 0, 0); PG8_LDB(B1, 0, 1); PG8_SCHED; PG8_LDA(At, 0, 0); PG8_STAGE_A(PG8_SA(1, 1), a1, va, 1);
            PG8_WAIT_V(8); PG8_WAIT_L(0); PG8_BAR; PG8_MMA(0, 0, At, B0); PG8_MMA(0, 1, At, B1); PG8_BAR; PG8_SCHED;
            PG8_LDA(At, 0, 1); PG8_STAGE(PG8_SB(0, 0), b2, voffB); PG8_STAGE(PG8_SB(0, 1), b2 + hstep, voffB); PG8_STAGE_A(PG8_SA(0, 0), a2, vs, 0);
            PG8_WAIT_V(8); PG8_WAIT_L(0); PG8_BAR; PG8_MMA(1, 0, At, B0); PG8_MMA(1, 1, At, B1); PG8_BAR; PG8_SCHED;
            PG8_LDB(B0, 1, 0); PG8_LDB(B1, 1, 1); PG8_SCHED; PG8_LDA(At, 1, 0); PG8_STAGE_A(PG8_SA(0, 1), a2, vs, 1);
            PG8_WAIT_V(8); PG8_WAIT_L(0); PG8_BAR; PG8_MMA(0, 0, At, B0); PG8_MMA(0, 1, At, B1); PG8_BAR; PG8_SCHED;
            PG8_LDA(At, 1, 1); PG8_STAGE(PG8_SB(1, 0), b3, voffB); PG8_STAGE(PG8_SB(1, 1), b3 + hstep, voffB); PG8_STAGE_A(PG8_SA(1, 0), a3, vs, 0);
            PG8_WAIT_V(8); PG8_WAIT_L(0); PG8_BAR; PG8_MMA(1, 0, At, B0); PG8_MMA(1, 1, At, B1); PG8_BAR; PG8_SCHED;
            } else {
            PG8_LDB(B0, 0, 0); PG8_SCHED; PG8_LDA(At, 0, 0); PG8_STAGE_A(PG8_SA(1, 1), a1, va, 1);
            PG8_WAIT_L(8); PG8_BAR; PG8_WAIT_L(0); PG8_MMA(0, 0, At, B0); PG8_BAR; PG8_SCHED;
            PG8_LDB(B1, 0, 1); PG8_STAGE(PG8_SB(0, 0), b2, voffB);
            PG8_BAR; PG8_WAIT_L(0); PG8_MMA(0, 1, At, B1); PG8_BAR;
            PG8_LDA(At, 0, 1); PG8_STAGE_A(PG8_SA(0, 0), a2, vs, 0);
            PG8_BAR; PG8_WAIT_L(0); PG8_MMA(1, 0, At, B0); PG8_BAR; PG8_SCHED;
            PG8_STAGE(PG8_SB(0, 1), b2 + hstep, voffB);
            PG8_WAIT_V(6); PG8_BAR; PG8_MMA(1, 1, At, B1); PG8_BAR;
            PG8_LDB(B0, 1, 0); PG8_SCHED; PG8_LDA(At, 1, 0); PG8_STAGE_A(PG8_SA(0, 1), a2, vs, 1);
            PG8_WAIT_L(8); PG8_BAR; PG8_WAIT_L(0); PG8_MMA(0, 0, At, B0); PG8_BAR; PG8_SCHED;
            PG8_LDB(B1, 1, 1); PG8_STAGE(PG8_SB(1, 0), b3, voffB);
            PG8_BAR; PG8_WAIT_L(0); PG8_MMA(0, 1, At, B1); PG8_BAR;
            PG8_LDA(At, 1, 1); PG8_STAGE_A(PG8_SA(1, 0), a3, vs, 0);
            PG8_BAR; PG8_WAIT_L(0); PG8_MMA(1, 0, At, B0); PG8_BAR; PG8_SCHED;
            PG8_STAGE(PG8_SB(1, 1), b3 + hstep, voffB);
            PG8_WAIT_V(6); PG8_BAR; PG8_MMA(1, 1, At, B1); PG8_BAR;
            }
        }
        if constexpr (ALIGN_EPI) { if (wr == 0) PG8_BAR; }
        if constexpr (!Epi::AFTER_DRAIN) { E(acc, cur, wr, wc, fr, fq); S.done(cur); }
        if (!has_next) break;
#pragma unroll
        for (int a = 0; a < 2; ++a)
#pragma unroll
            for (int b = 0; b < 2; ++b)
#pragma unroll
                for (int m = 0; m < 4; ++m)
#pragma unroll
                    for (int n = 0; n < 2; ++n) acc[a][b][m][n] = (f32x4){0.f, 0.f, 0.f, 0.f};
        cur = nxt; cB = nB; ++ui;
#pragma unroll
        for (int h_ = 0; h_ < 2; ++h_)
#pragma unroll
            for (int i_ = 0; i_ < 2; ++i_) va[h_][i_] = vn[h_][i_];
        if constexpr (ALIGN_EPI) { if (wr == 1) PG8_BAR; }
    }
    PG8_WAIT_V(0);
    if constexpr (!ALIGN_EPI) { if (wr == 0) PG8_BAR; }
    PG8_BAR;
    if constexpr (Epi::AFTER_DRAIN) { E.fused(acc, cur, wr, wc, fr, fq, lds, wid, lane); S.done(cur); }
#undef PG8_SA
#undef PG8_SB
#undef PG8_STAGE
#undef PG8_STAGE_A
#undef PG8_GATHER
#undef PG8_LDA
#undef PG8_LDB
#undef PG8_MMA
#undef PG8_WAIT_V
#undef PG8_WAIT_L
#undef PG8_BAR
#undef PG8_SCHED
}
}

constexpr int NWAVES = 8, NTHR = 512;
constexpr int BATCH = 4, SEQ = 4096, D = 2048, M = BATCH * SEQ;
constexpr int NH = 8, HD = 128;
constexpr int INW = 7192, NBIG = 7168;
constexpr int CONVCH = 3072;
constexpr int NG = 4, EPG = 8, NE = 32, DE = 512;
constexpr float EPS = 1e-6f;
constexpr int CHUNK = 64, NCH = SEQ / CHUNK;
constexpr int SLOT_CAP = 40960;

constexpr size_t MiB = 1u << 20;
constexpr size_t WS_CTL = 0, CTL_ZERO_BYTES = 1 * MiB;
constexpr size_t WS_WST = 1 * MiB;
constexpr size_t WS_WRT = 1 * MiB + 256 * 1024;
constexpr size_t WS_SMALL = 2 * MiB;
constexpr size_t WS_WINT = 4 * MiB;
constexpr size_t WS_WOUTT = 32 * MiB;
constexpr size_t WS_H = 40 * MiB;
constexpr size_t WS_QKVA = 104 * MiB;
constexpr size_t WS_Z = 200 * MiB;
constexpr size_t WS_QKVB = 232 * MiB;
constexpr size_t QKVB_STRIDE = (size_t)M * 1024;
constexpr size_t WS_MP = 40 * MiB;
constexpr size_t WS_SB = 104 * MiB;
constexpr size_t WS_NT = 328 * MiB;
constexpr size_t WS_QP = 392 * MiB;
constexpr size_t WS_OL = 424 * MiB;
constexpr size_t WS_W13T = 456 * MiB;
constexpr size_t WS_W2T = 584 * MiB;
constexpr size_t WS_CUMF = 648 * MiB;
constexpr size_t WS_RL = 649 * MiB;
constexpr size_t WS_ROUTE = 652 * MiB;
constexpr size_t WS_END = 656 * MiB;
constexpr size_t WS_Y = 104 * MiB;
constexpr size_t WS_HID = 328 * MiB;
static_assert(WS_Y + (size_t)SLOT_CAP * 2048 * 2 <= WS_HID && WS_HID + (size_t)SLOT_CAP * 512 * 2 <= WS_W13T, "moe overlays");
constexpr size_t RT_TOKE = 0;
constexpr size_t RT_TOKW = 128 * 1024;
constexpr size_t RT_TOKR = 256 * 1024;
constexpr size_t RT_LIST = 384 * 1024;
constexpr size_t RT_SLOTW = 640 * 1024;
constexpr size_t RT_TILEE = 896 * 1024;
constexpr int CW_TMO = 0, CW_CODE = 1;
constexpr int CW_BAR = 4096;
constexpr int CW_CNT = 8192;
constexpr int CW_MOD = 65536;
static_assert((CW_MOD + 4 * 12288) * 4 <= (int)CTL_ZERO_BYTES, "ctl");

constexpr int RING_BYTES = 147456;
constexpr int LDSCTL_OFF = RING_BYTES, MISC_OFF = LDSCTL_OFF + 320;
constexpr int LDS_BYTES = 163840;

#define GAS __attribute__((address_space(1)))
#define LAS __attribute__((address_space(3)))
typedef unsigned short bf16;
typedef unsigned v4u __attribute__((ext_vector_type(4)));
typedef unsigned v2u __attribute__((ext_vector_type(2)));
typedef float f32x4 __attribute__((ext_vector_type(4)));
typedef float f32x2 __attribute__((ext_vector_type(2)));
typedef short bf16x8 __attribute__((ext_vector_type(8)));
typedef GAS unsigned gu32;
#define RLX_AGENT __ATOMIC_RELAXED, __HIP_MEMORY_SCOPE_AGENT
#define LDS_WAIT() asm volatile("s_waitcnt lgkmcnt(0)" ::: "memory")
#define VM_WAIT() asm volatile("s_waitcnt vmcnt(0)" ::: "memory")
__device__ __forceinline__ unsigned f2bf(float f) { unsigned u = __builtin_bit_cast(unsigned, f); return (u + 0x7fffu + ((u >> 16) & 1u)) >> 16; }
__device__ __forceinline__ unsigned pk2(float lo, float hi) { return f2bf(lo) | (f2bf(hi) << 16); }
__device__ __forceinline__ float bf2f(unsigned short b) { return __builtin_bit_cast(float, ((unsigned)b) << 16); }
__device__ __forceinline__ float bflo(unsigned w) { return __builtin_bit_cast(float, w << 16); }
__device__ __forceinline__ float bfhi(unsigned w) { return __builtin_bit_cast(float, w & 0xffff0000u); }
__device__ __forceinline__ float wave_sum(float v) {
#pragma unroll
    for (int o = 1; o < 64; o <<= 1) v += __shfl_xor(v, o);
    return v;
}
__device__ __forceinline__ float siluf(float x) { return x / (1.f + __expf(-x)); }
__device__ __forceinline__ float sigmoidf_(float x) { return 1.f / (1.f + __expf(-x)); }
__device__ __forceinline__ float softplusf_(float x) { return x > 20.f ? x : log1pf(expf(x)); }
__device__ __forceinline__ float logsigmoidf_(float x) { return fminf(x, 0.f) - log1pf(expf(-fabsf(x))); }
#define XB_TMO      128
#define XB_XCNT(j)  (256  + 64 * (j))
#define XB_XSUB(j)  (1280 + 64 * (j))
#define XB_XGEN(j)  (2304 + 64 * (j))
#define XB_TOP      3328
#define XB_TOPGEN   3392
#define XCD_BAR_WORDS 3456
#define XB_SPIN_CAP (1u << 18)
#define XB_TMO      128
#define XB_XCNT(j)  (256  + 64 * (j))
#define XB_XSUB(j)  (1280 + 64 * (j))
#define XB_XGEN(j)  (2304 + 64 * (j))
#define XB_TOP      3328
#define XB_TOPGEN   3392
#define XCD_BAR_WORDS 3456
#define XB_SPIN_CAP (1u << 18)

__device__ __forceinline__ unsigned xb_ld(unsigned* p)              { return __hip_atomic_load(p, __ATOMIC_RELAXED, __HIP_MEMORY_SCOPE_AGENT); }
__device__ __forceinline__ unsigned xb_add(unsigned* p, unsigned v) { return __hip_atomic_fetch_add(p, v, __ATOMIC_RELAXED, __HIP_MEMORY_SCOPE_AGENT); }
__device__ __forceinline__ unsigned xb_xcc_id() { return (unsigned)__builtin_amdgcn_s_getreg((3 << 11) | 20) & 0xFu; }
#define XB_SPIN(cond, bar) do { unsigned _sp = 0; while (cond) { __builtin_amdgcn_s_sleep(1); \
    if ((++_sp & 255u) == 0u) { if (xb_ld(&(bar)[XB_TMO])) break; if (_sp > XB_SPIN_CAP) { atomicAdd(&(bar)[XB_TMO], 1u); break; } } } } while (0)

struct XcdBarrier {
    unsigned* bar; unsigned x;
    volatile LAS unsigned* st;
};

__device__ __forceinline__ XcdBarrier xcd_barrier_post(unsigned* bar, volatile LAS unsigned* st) {
    XcdBarrier b; b.bar = bar; b.x = xb_xcc_id(); b.st = st;
    if (threadIdx.x == 0) (void)xb_add(&bar[XB_XCNT(b.x)], 1u);
    return b;
}
__device__ __forceinline__ void xcd_barrier_complete(unsigned* bar, unsigned x, unsigned& nloc, unsigned& nx) {
    const unsigned G = gridDim.x * gridDim.y * gridDim.z;
    unsigned sum, cnt, mine, sp = 0u;
    for (;;) {
        sum = 0u; cnt = 0u; mine = 0u;
#pragma unroll
        for (unsigned j = 0; j < 16; ++j) { const unsigned c = xb_ld(&bar[XB_XCNT(j)]); sum += c; cnt += (c > 0u) ? 1u : 0u; mine = (j == x) ? c : mine; }
        if (sum == G) break;
        __builtin_amdgcn_s_sleep(1);
        if ((++sp & 255u) == 0u) { if (xb_ld(&bar[XB_TMO])) break; if (sp > XB_SPIN_CAP) { atomicAdd(&bar[XB_TMO], 1u); break; } }
    }
    nloc = mine > 0u ? mine : 1u; nx = cnt > 0u ? cnt : 1u;
}

__device__ __forceinline__ void xcd_barrier(const XcdBarrier& b) {
    asm volatile("s_waitcnt vmcnt(0)" ::: "memory");
    __syncthreads();
    if (threadIdx.x == 0) {
        unsigned* bar = b.bar;
        __builtin_amdgcn_s_waitcnt(0);
        unsigned nloc = b.st[0], nx = b.st[1];
        if (nloc == 0u) { xcd_barrier_complete(bar, b.x, nloc, nx); b.st[0] = nloc; b.st[1] = nx; }
        const unsigned old = xb_add(&bar[XB_XSUB(b.x)], 1u);
        const unsigned gen = old / nloc;
        if (old + 1u == (gen + 1u) * nloc) {
            __builtin_amdgcn_fence(__ATOMIC_RELEASE, "agent");
            asm volatile("s_waitcnt vmcnt(0)" ::: "memory");
            const unsigned og = xb_add(&bar[XB_TOP], 1u);
            const unsigned tg = og / nx;
            if (og + 1u == (tg + 1u) * nx) xb_add(&bar[XB_TOPGEN], 1u);
            else XB_SPIN(xb_ld(&bar[XB_TOPGEN]) == tg, bar);
            __builtin_amdgcn_fence(__ATOMIC_ACQUIRE, "agent");
            xb_add(&bar[XB_XGEN(b.x)], 1u);
            asm volatile("s_waitcnt vmcnt(0)" ::: "memory");
        } else {
            XB_SPIN(xb_ld(&bar[XB_XGEN(b.x)]) == gen, bar);
            __builtin_amdgcn_fence(__ATOMIC_ACQUIRE, "agent");
            asm volatile("s_waitcnt vmcnt(0)" ::: "memory");
        }
    }
    __syncthreads();
}

namespace fa {
using TIN = unsigned short; using TOUT = unsigned short;
constexpr int B = 4, H = 8, HKV = 8, SQ = 4096, SKV = 4096, D = 128, QOFF = 0, WINDOW = SKV;
constexpr float THR = 8.f;
constexpr bool WSKIP = false;
constexpr int OPITCH = 2048;
constexpr float SCALE = 0.08838834764831845f;
constexpr int NW = 8, QBLK = 32, KVBLK = 64, QB = NW * QBLK;
constexpr int SHM_V = KVBLK * D * 2, SHM_K = KVBLK * D * 2;
constexpr int LDS_BYTES = 2 * SHM_V + 2 * SHM_K + NW * 64 * 4;
constexpr int LDS_FB = LDS_BYTES;
typedef short bf16x8 __attribute__((ext_vector_type(8)));
typedef short s16x4 __attribute__((ext_vector_type(4)));
typedef float f32x16 __attribute__((ext_vector_type(16)));
typedef float f32x4 __attribute__((ext_vector_type(4)));
typedef unsigned u32x4 __attribute__((ext_vector_type(4)));
template <class A, class Bt> struct same_t { static constexpr bool v = false; };
template <class A> struct same_t<A, A> { static constexpr bool v = true; };

#define KSWZ(row, colB) ((row) * 256 + ((colB) ^ (((row) & 7) << 4)))
#define SBAR() __builtin_amdgcn_sched_barrier(0)
__device__ __forceinline__ int v_st(int k, int c) { const int kk = (k & ~0xC) | ((k & 4) << 1) | ((k & 8) >> 1); return ((kk >> 3) * 4 + (c >> 5)) * 512 + ((kk & 7) * 32 + (c & 31)) * 2; }
__device__ __forceinline__ int v_rd_base(int lane) { return ((lane & 3) << 3) | (((lane >> 2) & 3) << 6) | (((lane >> 4) & 1) << 5) | (((lane >> 5) & 1) << 8); }
constexpr int v_rd_off(int d0, int ks, int half) { return d0 * 512 + ks * 4096 + half * 2048; }
__device__ __forceinline__ int crow(int r, int hi) { return (r & 3) + 8 * (r >> 2) + 4 * hi; }
__device__ __forceinline__ unsigned cvtpk(float lo, float hi) {
    unsigned r; asm volatile("v_cvt_pk_bf16_f32 %0, %1, %2" : "=v"(r) : "v"(lo), "v"(hi)); return r;
}
__device__ __forceinline__ bf16x8 pack8(f32x4 a, f32x4 b) {
    u32x4 w = {cvtpk(a[0], a[1]), cvtpk(a[2], a[3]), cvtpk(b[0], b[1]), cvtpk(b[2], b[3])};
    return *reinterpret_cast<bf16x8*>(&w);
}
template <class T> __device__ __forceinline__ bf16x8 load8(const T* p) {
    if constexpr (same_t<T, float>::v) { return pack8(*(const f32x4*)p, *(const f32x4*)(p + 4)); }
    else { return *reinterpret_cast<const bf16x8*>(p); }
}
__device__ __forceinline__ void mask_tile(f32x16& p0, f32x16& p1, int dq, unsigned W) {
    const float NEG = -__builtin_inff();
#pragma unroll
    for (int r = 0; r < 16; ++r) {
        const int c = (r & 3) + 8 * (r >> 2);
        if ((unsigned)(dq - c) >= W) p0[r] = NEG;
        if ((unsigned)(dq - c - 32) >= W) p1[r] = NEG;
    }
}
__device__ __forceinline__ void partialSM(f32x16& p0, f32x16& p1, float& m_reg, float& mn, float& alpha) {
    float pmax = p0[0]; for (int r = 1; r < 16; ++r) pmax = fmaxf(pmax, p0[r]); for (int r = 0; r < 16; ++r) pmax = fmaxf(pmax, p1[r]);
    { auto rr = __builtin_amdgcn_permlane32_swap(__float_as_uint(pmax), __float_as_uint(pmax), false, false);
      pmax = fmaxf(__uint_as_float(rr[0]), __uint_as_float(rr[1])); }
    constexpr float C2 = 1.4426950408889634f * SCALE;
    if (__builtin_expect(__all((pmax - m_reg) * SCALE <= THR), 1)) { mn = m_reg; alpha = 1.f; }
    else { mn = fmaxf(m_reg, pmax); alpha = __builtin_amdgcn_exp2f((m_reg - mn) * C2); m_reg = mn; }
    const float mnL = -mn * C2;
    for (int r = 0; r < 16; ++r) p0[r] = fmaf(p0[r], C2, mnL); for (int r = 0; r < 16; ++r) p1[r] = fmaf(p1[r], C2, mnL);
    for (int r = 0; r < 16; ++r) p0[r] = __builtin_amdgcn_exp2f(p0[r]);
}
__device__ __forceinline__ void finishSM(f32x16& p0, f32x16& p1, float alpha, float& l_reg, bf16x8& pa0, bf16x8& pa1, bf16x8& pa2, bf16x8& pa3) {
    for (int r = 0; r < 16; ++r) p1[r] = __builtin_amdgcn_exp2f(p1[r]);
    float ps = 0; for (int r = 0; r < 16; ++r) ps += p0[r]; for (int r = 0; r < 16; ++r) ps += p1[r];
    { auto rr = __builtin_amdgcn_permlane32_swap(__float_as_uint(ps), __float_as_uint(ps), false, false);
      ps = __uint_as_float(rr[0]) + __uint_as_float(rr[1]); }
    l_reg = l_reg * alpha + ps;
#define PK4(P, B_, OUT) do { unsigned a0 = cvtpk(P[B_+0], P[B_+1]), a1 = cvtpk(P[B_+2], P[B_+3]);                          \
        unsigned b0 = cvtpk(P[B_+4], P[B_+5]), b1 = cvtpk(P[B_+6], P[B_+7]);                                             \
        auto r0 = __builtin_amdgcn_permlane32_swap(a0, b0, false, false); auto r1 = __builtin_amdgcn_permlane32_swap(a1, b1, false, false); \
        u32x4 w = {r0[0], r1[0], r0[1], r1[1]}; OUT = *reinterpret_cast<bf16x8*>(&w); } while (0)
    PK4(p0, 0, pa0); PK4(p0, 8, pa1); PK4(p1, 0, pa2); PK4(p1, 8, pa3);
#undef PK4
}
template <int KB, bool SK>
__device__ __forceinline__ void qkt(f32x16& p0, f32x16& p1, const char* K_lds, int r32, int hi, const bf16x8* qr, bool act) {
    if (SK && !act) { const float NEG = -__builtin_inff();
#pragma unroll
        for (int r = 0; r < 16; ++r) { p0[r] = NEG; p1[r] = NEG; } return; }
    { const char* fb = K_lds + 2 * SHM_K + NW * 64 * 4 + KB * 256 + hi * 16;
#pragma unroll
      for (int g = 0; g < 4; ++g) { const f32x4 t0 = *reinterpret_cast<const f32x4*>(fb + g * 32), t1 = *reinterpret_cast<const f32x4*>(fb + 128 + g * 32);
#pragma unroll
          for (int e = 0; e < 4; ++e) { p0[4 * g + e] = t0[e]; p1[4 * g + e] = t1[e]; } } }
    const char* kb[4];
#pragma unroll
    for (int dd = 0; dd < 4; ++dd) kb[dd] = K_lds + KB * SHM_K + KSWZ(r32, (dd * 16 + hi * 8) * 2);
#pragma unroll
    for (int d0 = 0; d0 < 8; ++d0) { const char* a = kb[d0 & 3] + (d0 >> 2) * 128;
        bf16x8 b0 = *reinterpret_cast<const bf16x8*>(a);
        bf16x8 b1 = *reinterpret_cast<const bf16x8*>(a + 32 * 256);
        p0 = __builtin_amdgcn_mfma_f32_32x32x16_bf16(b0, qr[d0], p0, 0, 0, 0);
        p1 = __builtin_amdgcn_mfma_f32_32x32x16_bf16(b1, qr[d0], p1, 0, 0, 0); }
}
template <int VB, bool SK>
__device__ __forceinline__ void pv_tile(f32x16* o, int vb0, bf16x8 pa0, bf16x8 pa1, bf16x8 pa2, bf16x8 pa3, bool act) {
    if (SK && !act) return;
#define TRRD(dst, off) asm volatile("ds_read_b64_tr_b16 %0, %1 offset:%2" : "=&v"(dst) : "v"(vb0), "i"(off) : "memory")
#define PV_D0(d0) do { s16x4 l0, l1, l2, l3, h0, h1, h2, h3; constexpr int b_ = VB * SHM_V + v_rd_off(d0, 0, 0);     \
        TRRD(l0, b_); TRRD(h0, b_ + 2048); TRRD(l1, b_ + 4096); TRRD(h1, b_ + 6144); TRRD(l2, b_ + 8192); TRRD(h2, b_ + 10240); TRRD(l3, b_ + 12288); TRRD(h3, b_ + 14336); \
        asm volatile("s_waitcnt lgkmcnt(0)" ::: "memory"); SBAR();                 \
        o[d0] = __builtin_amdgcn_mfma_f32_32x32x16_bf16(pa0, (bf16x8){l0[0], l0[1], l0[2], l0[3], h0[0], h0[1], h0[2], h0[3]}, o[d0], 0, 0, 0);   \
        o[d0] = __builtin_amdgcn_mfma_f32_32x32x16_bf16(pa1, (bf16x8){l1[0], l1[1], l1[2], l1[3], h1[0], h1[1], h1[2], h1[3]}, o[d0], 0, 0, 0);   \
        o[d0] = __builtin_amdgcn_mfma_f32_32x32x16_bf16(pa2, (bf16x8){l2[0], l2[1], l2[2], l2[3], h2[0], h2[1], h2[2], h2[3]}, o[d0], 0, 0, 0);   \
        o[d0] = __builtin_amdgcn_mfma_f32_32x32x16_bf16(pa3, (bf16x8){l3[0], l3[1], l3[2], l3[3], h3[0], h3[1], h3[2], h3[3]}, o[d0], 0, 0, 0); } while (0)
    PV_D0(0); PV_D0(1); PV_D0(2); PV_D0(3);
#undef PV_D0
#undef TRRD
}

template <class TIn, class TOut> struct BlockRef { const TIn* Q; const TIn* K; const TIn* V; TOut* O; const float* FB; int P0; };
template <class TIn> struct Seam {
    bf16x8 qr[8];
    bf16x8 st_v0, st_v1, st_k0, st_k1; f32x4 sf0, sf1, sf2, sf3; float st_f;
    f32x4 tq[16];
};
__device__ __forceinline__ int swa_jlo(int P0, int W) { const int lowk = P0 - W + 1; return lowk > 0 ? lowk / KVBLK : 0; }
#define ROW(p, k0, rr) ((p) + (size_t)((k0) + (rr)) * D + sc)
#define VMW() asm volatile("s_waitcnt vmcnt(0)" ::: "memory")
#define VMWN(n) asm volatile("s_waitcnt vmcnt(%0)" :: "i"(n) : "memory")
#define SLOAD_H(Kp, Vp, Fp, k0) do { S.st_v0 = load8<TIn>(ROW(Vp, k0, sr)); S.st_v1 = load8<TIn>(ROW(Vp, k0, 32 + sr));              \
                         S.st_k0 = load8<TIn>(ROW(Kp, k0, sr)); S.st_k1 = load8<TIn>(ROW(Kp, k0, 32 + sr)); S.st_f = (Fp)[(k0) + (tid & 63)]; } while (0)
#define SWRITE_HK(bf) do { *(bf16x8*)(K_lds + (bf) * SHM_K + kws) = S.st_k0; *(bf16x8*)(K_lds + (bf) * SHM_K + kws + 32 * 256) = S.st_k1; if (tid < 64) *(float*)(K_lds + 2 * SHM_K + NW * 64 * 4 + (bf) * 256 + tid * 4) = S.st_f; } while (0)
#define SWRITE_HV(bf) do { *(bf16x8*)(V_lds + (bf) * SHM_V + vst0) = S.st_v0; *(bf16x8*)(V_lds + (bf) * SHM_V + vst1) = S.st_v1; } while (0)
#define SWRITE_H(bf) do { SWRITE_HV(bf); SWRITE_HK(bf); } while (0)
#define SLOAD_F(p, k0) do { S.sf0 = *(const f32x4*)ROW(p, k0, sr); S.sf1 = *(const f32x4*)(ROW(p, k0, sr) + 4);                \
                            S.sf2 = *(const f32x4*)ROW(p, k0, 32 + sr); S.sf3 = *(const f32x4*)(ROW(p, k0, 32 + sr) + 4); } while (0)
#define SWRITE_KF(bf) do { *(bf16x8*)(K_lds + (bf) * SHM_K + kws) = pack8(S.sf0, S.sf1); *(bf16x8*)(K_lds + (bf) * SHM_K + kws + 32 * 256) = pack8(S.sf2, S.sf3); } while (0)
#define SWRITE_VF(bf) do { *(bf16x8*)(V_lds + (bf) * SHM_V + vst0) = pack8(S.sf0, S.sf1); *(bf16x8*)(V_lds + (bf) * SHM_V + vst1) = pack8(S.sf2, S.sf3); } while (0)
template <class TIn, class TOut>
__device__ __forceinline__ void causal_swa_prime(const BlockRef<TIn, TOut>& cur, int W, char* lds, Seam<TIn>& S) {
    constexpr bool F32 = same_t<TIn, float>::v;
    const int tid = threadIdx.x, wid = __builtin_amdgcn_readfirstlane(tid >> 6), lane = tid & 63, r32 = lane & 31, hi = lane >> 5;
    const int sr = tid >> 4, sc = (tid & 15) * 8, kws = KSWZ(sr, sc * 2); char* K_lds = lds + 2 * SHM_V;
    const int kb0 = swa_jlo(cur.P0, W) * KVBLK;
    for (int d0 = 0; d0 < 8; ++d0) S.qr[d0] = load8<TIn>(cur.Q + (size_t)(wid * QBLK + r32) * D + d0 * 16 + hi * 8);
    if constexpr (F32) { SLOAD_F((const float*)cur.K, kb0); VMW(); SWRITE_KF(0); SBAR(); SLOAD_F((const float*)cur.V, kb0); }
    else { SLOAD_H(cur.K, cur.V, cur.FB, kb0); VMW(); SWRITE_HK(0); }
    __syncthreads();
}
template <class TIn, class TOut>
__device__ __forceinline__ void causal_swa_block(const BlockRef<TIn, TOut>& cur, const BlockRef<TIn, TOut>& nxt, int skv, int W, char* lds, Seam<TIn>& S) {
    constexpr bool F32 = same_t<TIn, float>::v;
    const int tid = threadIdx.x, wid = __builtin_amdgcn_readfirstlane(tid >> 6), lane = tid & 63, r32 = lane & 31, hi = lane >> 5;
    const int j_lo = swa_jlo(cur.P0, W);
    int j_hi = (cur.P0 + QB - 1) / KVBLK + 1; if (j_hi > skv / KVBLK) j_hi = skv / KVBLK;
    const int NT = j_hi - j_lo;
    const int kbn = swa_jlo(nxt.P0, W) * KVBLK;
    const int qlo = cur.P0 + wid * QBLK, qm = qlo + r32 - 4 * hi;
    char* V_lds = lds; char* K_lds = lds + 2 * SHM_V;
    float* ws = (float*)(lds + 2 * SHM_V + 2 * SHM_K) + wid * 64; float* li_l = ws, * al_l = ws + 32;
    float m_reg = -1e30f, l_reg = 0; f32x16 o[4] = {};
    const int sr = tid >> 4, sc = (tid & 15) * 8, vst0 = v_st(sr, sc), vst1 = v_st(32 + sr, sc), kws = KSWZ(sr, sc * 2);
    const int vb0 = (int)(uintptr_t)V_lds + v_rd_base(lane);
    const TIn* Kh = cur.K; const TIn* Vh = cur.V; const float* Fh = cur.FB;
#define RESC(a) do { if (__any((a) < 1.f)) { if (hi == 0) al_l[r32] = (a); asm volatile("s_waitcnt lgkmcnt(0)" ::: "memory");              \
                     for (int d_ = 0; d_ < 4; ++d_) for (int r = 0; r < 16; ++r) o[d_][r] *= al_l[crow(r, hi)]; } } while (0)
#define KBASE(t) ((j_lo + (t)) * KVBLK)
#define ACT(t) (KBASE(t) <= qlo + QBLK - 1 && KBASE(t) + KVBLK - 1 >= qlo - W + 1)
#define MASKT(P0_, P1_, t) do { const int kb_ = KBASE(t); if ((!SK || ACT(t)) && (kb_ + KVBLK - 1 > qlo || kb_ <= qlo + QBLK - 1 - W)) mask_tile(P0_, P1_, qm - kb_, (unsigned)W); } while (0)
    constexpr int NQL = F32 ? 16 : 8;
    constexpr bool SK = WSKIP && !F32;
#define SEAM_K0() do { VMWN(NQL); if constexpr (F32) { SWRITE_KF(0); SBAR(); SLOAD_F((const float*)nxt.V, kbn); } else { SWRITE_HK(0); } SBAR(); } while (0)
    f32x16 pA0, pA1, pB0, pB1; float mnA, mnB, alA, alB; bf16x8 pa0, pa1, pa2, pa3;
    if constexpr (F32) { VMW(); SWRITE_VF(0); SBAR(); } else { SWRITE_HV(0); SBAR(); }
    if (NT > 1) { if constexpr (F32) SLOAD_F((const float*)Kh, KBASE(1)); else SLOAD_H(Kh, Vh, Fh, KBASE(1)); }
    SBAR(); qkt<0, SK>(pA0, pA1, K_lds, r32, hi, S.qr, ACT(0));
    if constexpr (F32) { if (NT > 1) { VMW(); SWRITE_KF(1); SBAR(); SLOAD_F((const float*)Vh, KBASE(1)); } }
    MASKT(pA0, pA1, 0); partialSM(pA0, pA1, m_reg, mnA, alA);
    if (NT > 1) { VMW(); if constexpr (F32) { SWRITE_VF(1); SBAR(); if (NT > 2) SLOAD_F((const float*)Kh, KBASE(2)); } else SWRITE_H(1); }
    __syncthreads();
#define HALF_STEP(PX0, PX1, mnX, alX, PY0, PY1, alY, t, KB, VB, SB) do {                                                      \
        SBAR(); qkt<KB, SK>(PX0, PX1, K_lds, r32, hi, S.qr, ACT(t));                                             \
        finishSM(PY0, PY1, alY, l_reg, pa0, pa1, pa2, pa3); SBAR();                                                           \
        if ((t) + 1 < NT) { if constexpr (F32) { VMW(); SWRITE_KF(SB); SBAR(); SLOAD_F((const float*)Vh, KBASE((t) + 1)); }  \
                            else { SLOAD_H(Kh, Vh, Fh, KBASE((t) + 1)); } SBAR(); }                                               \
        pv_tile<VB, SK>(o, vb0, pa0, pa1, pa2, pa3, ACT((t) - 1)); MASKT(PX0, PX1, (t)); partialSM(PX0, PX1, m_reg, mnX, alX);                                        \
        __syncthreads();                                                                                                      \
        if ((t) + 1 < NT) { VMW(); if constexpr (F32) { SWRITE_VF(SB); SBAR(); if ((t) + 2 < NT) SLOAD_F((const float*)Kh, KBASE((t) + 2)); } \
                            else { SWRITE_H(SB); } }                                                                          \
        RESC(alX); __syncthreads(); } while (0)
    for (int t = 1; t + 1 < NT; t += 2) {
        HALF_STEP(pB0, pB1, mnB, alB, pA0, pA1, alA, t, 1, 0, 0);
        HALF_STEP(pA0, pA1, mnA, alA, pB0, pB1, alB, t + 1, 0, 1, 1);
    }
    const bool even = (NT & 1) == 0;
    if (even) { SBAR(); qkt<1, SK>(pB0, pB1, K_lds, r32, hi, S.qr, ACT(NT - 1)); SBAR(); }
#define QROW(e) (nxt.Q + (size_t)(wid * QBLK + r32) * D + ((e) >> 1) * 16 + hi * 8 + ((e) & 1) * 4)
    if constexpr (F32) { SLOAD_F((const float*)nxt.K, kbn); SBAR();
#pragma unroll
        for (int e = 0; e < 8; ++e) S.tq[e] = *(const f32x4*)QROW(e); }
    else { SLOAD_H(nxt.K, nxt.V, nxt.FB, kbn); SBAR();
#pragma unroll
        for (int d0 = 0; d0 < 8; ++d0) S.qr[d0] = load8<TIn>(nxt.Q + (size_t)(wid * QBLK + r32) * D + d0 * 16 + hi * 8); }
    SBAR();
    finishSM(pA0, pA1, alA, l_reg, pa0, pa1, pa2, pa3); SBAR();
    if constexpr (F32) {
#pragma unroll
        for (int e = 8; e < 16; ++e) S.tq[e] = *(const f32x4*)QROW(e); SBAR(); }
#undef QROW
    pv_tile<0, SK>(o, vb0, pa0, pa1, pa2, pa3, ACT(even ? NT - 2 : NT - 1));
    if (even) { MASKT(pB0, pB1, NT - 1); partialSM(pB0, pB1, m_reg, mnB, alB); __syncthreads(); RESC(alB);
        finishSM(pB0, pB1, alB, l_reg, pa0, pa1, pa2, pa3); SBAR(); pv_tile<1, SK>(o, vb0, pa0, pa1, pa2, pa3, ACT(NT - 1)); }
    SBAR(); SEAM_K0();
    if (hi == 0) li_l[r32] = l_reg; asm volatile("s_waitcnt lgkmcnt(0)" ::: "memory");
    float rli[16];
#pragma unroll
    for (int r = 0; r < 16; ++r) rli[r] = __builtin_amdgcn_rcpf(li_l[crow(r, hi)]);
    TOut* Ow = cur.O + (size_t)(wid * QBLK) * OPITCH;
#pragma unroll
    for (int r = 0; r < 16; ++r) { const int orow = crow(r, hi);
#pragma unroll
        for (int d0 = 0; d0 < 4; ++d0) { const float v = o[d0][r] * rli[r];
            if constexpr (same_t<TOut, float>::v) { Ow[(size_t)orow * OPITCH + d0 * 32 + r32] = v; }
            else { const float vn = __shfl_xor(v, 1);
                   if ((r32 & 1) == 0) *(unsigned*)(Ow + (size_t)orow * OPITCH + d0 * 32 + r32) = cvtpk(v, vn); } } }
    if constexpr (F32) {
#pragma unroll
        for (int d0 = 0; d0 < 8; ++d0) S.qr[d0] = pack8(S.tq[2 * d0], S.tq[2 * d0 + 1]); }
    __syncthreads();
#undef RESC
#undef KBASE
#undef ACT
#undef MASKT
#undef SEAM_K0
#undef HALF_STEP
}
#undef ROW
#undef VMW
#undef VMWN
#undef SLOAD_H
#undef SWRITE_HK
#undef SWRITE_HV
#undef SWRITE_H
#undef SLOAD_F
#undef SWRITE_KF
#undef SWRITE_VF

}

struct Args { const float* in[21]; float* out; unsigned char* ws; int ph_lo, ph_hi; };
template <int OFF> __device__ __forceinline__ unsigned long long karg64() { unsigned long long v; asm volatile("s_load_dwordx2 %0, %1, %2\n\ts_waitcnt lgkmcnt(0)" : "=s"(v) : "s"(__builtin_amdgcn_kernarg_segment_ptr()), "n"(OFF) : "memory"); return v; }
#define ARG_IN(i) ((const float*)(const GAS float*)karg64<(i) * 8>())
#define ARG_OUT ((float*)(GAS float*)karg64<168>())
#define ARG_WS ((unsigned char*)(GAS unsigned char*)karg64<176>())
struct Frame {
    LAS unsigned char* lds; volatile LAS unsigned* MISC; unsigned* ctl;
    int tid, lane, wave, vcu, G, gw, NGW;
};

struct EpiProj {
    static constexpr bool PERM = true, AFTER_DRAIN = false;
    bf16* QKVA; bf16* Z; bf16* QKVB;
    __device__ __forceinline__ void operator()(const pg8::f32x4 (&acc)[2][2][4][2], const pg8::Unit& u, int wr, int wc, int fr, int fq) const {
        const int row0 = u.pm * 256 + wr * 64 + fr, pn = u.pn, cin = wc * 32 + 8 * fq;
#pragma unroll
        for (int ai = 0; ai < 2; ++ai)
#pragma unroll
            for (int m = 0; m < 4; ++m) { const int row = row0 + ai * 128 + m * 16;
#pragma unroll
                for (int bj = 0; bj < 2; ++bj) { const pg8::f32x4 v0 = acc[ai][bj][m][0], v1 = acc[ai][bj][m][1];
                    v4u w; w.x = pg8::cvt_pk_bf16(v0[0], v0[1]); w.y = pg8::cvt_pk_bf16(v0[2], v0[3]); w.z = pg8::cvt_pk_bf16(v1[0], v1[1]); w.w = pg8::cvt_pk_bf16(v1[2], v1[3]);
                    bf16* dst;
                    if (pn < 12) dst = QKVA + (size_t)row * 3072 + pn * 256 + bj * 128 + cin;
                    else if (pn < 16) dst = Z + (size_t)row * 1024 + (pn - 12) * 256 + bj * 128 + cin;
                    else { const int q = pn - 16, tensor = q >> 2, head = (q & 3) * 2 + bj, b = row >> 12, t = row & 4095;
                        dst = QKVB + (size_t)tensor * QKVB_STRIDE + ((size_t)((b * NH + head) * SEQ + t)) * HD + cin; }
                    *(v4u*)dst = w; } }
    }
};
struct EpiMix {
    static constexpr bool PERM = false, AFTER_DRAIN = false;
    const float* x; const float* mod; float* out;
    __device__ __forceinline__ void operator()(const pg8::f32x4 (&acc)[2][2][4][2], const pg8::Unit& u, int wr, int wc, int fr, int fq) const {
        const int row0 = u.pm * 256 + wr * 64 + fr, col0 = u.pn * 256 + wc * 32 + 4 * fq, b = u.pm >> 4;
        f32x4 gv[2][2];
#pragma unroll
        for (int bj = 0; bj < 2; ++bj)
#pragma unroll
            for (int n = 0; n < 2; ++n) gv[bj][n] = *(const f32x4*)(mod + b * 12288 + 2 * D + col0 + bj * 128 + n * 16);
#pragma unroll
        for (int ai = 0; ai < 2; ++ai)
#pragma unroll
            for (int m = 0; m < 4; ++m) { const size_t off = (size_t)(row0 + ai * 128 + m * 16) * D + col0;
#pragma unroll
                for (int bj = 0; bj < 2; ++bj)
#pragma unroll
                    for (int n = 0; n < 2; ++n) { const f32x4 xv = *(const f32x4*)(x + off + bj * 128 + n * 16);
                        *(f32x4*)(out + off + bj * 128 + n * 16) = xv + gv[bj][n] * acc[ai][bj][m][n]; } }
    }
};

__device__ __forceinline__ void transpose_item(const float* W, int ldw, int csrc, bf16* WT, int ldt, int drow0, int k0, LAS float* scr, int lane, int mode) {
#pragma unroll 8
    for (int i = 0; i < 32; ++i) { const int kk = 2 * i + (lane >> 5); scr[kk * 33 + (lane & 31)] = W[(size_t)(k0 + kk) * ldw + csrc + (lane & 31)]; }
    LDS_WAIT(); asm volatile("" ::: "memory");
    const int c = lane & 7;
#pragma unroll
    for (int j = 0; j < 4; ++j) { const int n = (lane >> 3) + 8 * j; const LAS float* s = scr + (8 * c) * 33 + n;
        v4u o; o.x = pk2(s[0 * 33], s[1 * 33]); o.y = pk2(s[2 * 33], s[3 * 33]); o.z = pk2(s[4 * 33], s[5 * 33]); o.w = pk2(s[6 * 33], s[7 * 33]);
        int dr;
        if (mode == 0) dr = drow0 + n;
        else dr = drow0 + ((n >> 4) << 5) + (n & 15) + (mode == 2 ? 16 : 0);
        *(GAS v4u*)(WT + (size_t)dr * ldt + k0 + 8 * c) = o; }
    LDS_WAIT(); asm volatile("" ::: "memory");
}
__device__ __forceinline__ void p0_prologue(Frame& F, const Args& A) {
    LAS float* scr = (LAS float*)(F.lds + F.wave * 16384);
    unsigned char* ws = ARG_WS;
    const float* w_in = ARG_IN(5); const float* w_out = ARG_IN(11);
    bf16* WINT = (bf16*)(ws + WS_WINT); bf16* WOUTT = (bf16*)(ws + WS_WOUTT);
    constexpr int I_G = 32 * 32, I_IN = 7 * I_G, I_OUT = 32 * 64, I_E13 = 32 * 16, I_13 = NE * I_E13, I_E2 = 8 * 64, I_2 = NE * I_E2;
    bf16* W13T = (bf16*)(ws + WS_W13T); bf16* W2T = (bf16*)(ws + WS_W2T);
    for (int it = F.gw; it < I_IN + I_OUT + 2 * I_13 + I_2; it += F.NGW) {
        if (it < I_IN) { const int g = it / I_G, r = it % I_G, kb = r / 32, nb = r % 32;
            const int src0 = (g < 4) ? g * 1024 : 4112 + (g - 4) * 1024;
            transpose_item(w_in, INW, src0 + nb * 32, WINT, D, g * 1024 + nb * 32, kb * 64, scr, F.lane, 0); }
        else if (it < I_IN + I_OUT) { const int r = it - I_IN, kb = r / 64, nb = r % 64;
            transpose_item(w_out, D, nb * 32, WOUTT, D, nb * 32, kb * 64, scr, F.lane, 0); }
        else if (it < I_IN + I_OUT + 2 * I_13) { int r = it - I_IN - I_OUT; const int which = r / I_13; r %= I_13; const int e = r / I_E13, q = r % I_E13, kb = q / 16, nb = q % 16;
            transpose_item((which ? ARG_IN(18) : ARG_IN(17)) + (size_t)e * D * DE, DE, nb * 32, W13T + (size_t)e * 1024 * D, D, nb * 64, kb * 64, scr, F.lane, which ? 2 : 1); }
        else { const int r = it - I_IN - I_OUT - 2 * I_13, e = r / I_E2, q = r % I_E2, kb = q / 64, nb = q % 64;
            transpose_item(ARG_IN(19) + (size_t)e * DE * D, D, nb * 32, W2T + (size_t)e * D * DE, DE, nb * 32, kb * 64, scr, F.lane, 0); }
    }
    { bf16* WST = (bf16*)(ws + WS_WST); bf16* WRT = (bf16*)(ws + WS_WRT); const float* w_rg = ARG_IN(13); const float* w_re = ARG_IN(15);
      const int gt = F.vcu * NTHR + F.tid, NT_ = F.G * NTHR;
      for (int i = gt; i < 80 * 2048; i += NT_) { const int n = i >> 11, k = i & 2047;
          if (n < 32) { float v = 0.f; if (n < 8) v = w_in[(size_t)k * INW + 4096 + n]; else if (n < 16) v = w_in[(size_t)k * INW + 4104 + (n - 8)]; else if (n < 24) v = w_in[(size_t)k * INW + 7184 + (n - 16)];
              WST[n * 2048 + k] = (bf16)f2bf(v); }
          else { const int r = n - 32; float v = 0.f; if (r < 4) v = w_rg[k * 4 + r]; else if (r < 36) v = w_re[k * 32 + (r - 4)];
              WRT[r * 2048 + k] = (bf16)f2bf(v); } } }
    { const float* cvec = ARG_IN(1); const float* w_ada = ARG_IN(2); const float* b_ada = ARG_IN(3); float* mod = (float*)(F.ctl + CW_MOD);
      __syncthreads();
      LAS float* sc = (LAS float*)F.lds;
      LAS float* red = sc + 8192;
      for (int i = F.tid; i < 4 * D; i += NTHR) sc[i] = siluf(cvec[i]);
      LDS_WAIT(); __syncthreads();
      const int cl = F.tid & 15, kg = F.tid >> 4;
      for (int cb = F.vcu; cb < 192; cb += F.G) { const int n0 = cb * 64 + 4 * cl;
          f32x4 acc[4];
#pragma unroll
          for (int b = 0; b < 4; ++b) acc[b] = (f32x4){0.f, 0.f, 0.f, 0.f};
#pragma unroll 4
          for (int it = 0; it < 64; ++it) { const int k = kg + 32 * it; const f32x4 w = *(const GAS f32x4*)(w_ada + (size_t)k * 12288 + n0);
#pragma unroll
              for (int b = 0; b < 4; ++b) acc[b] += sc[b * D + k] * w; }
#pragma unroll
          for (int b = 0; b < 4; ++b)
#pragma unroll
              for (int j = 0; j < 4; ++j) { float v = acc[b][j]; v += __shfl_xor(v, 16); v += __shfl_xor(v, 32); acc[b][j] = v; }
          if (F.lane < 16) {
#pragma unroll
              for (int b = 0; b < 4; ++b) *(LAS f32x4*)(red + (F.wave * 4 + b) * 64 + 4 * cl) = acc[b]; }
          LDS_WAIT(); __syncthreads();
          if (F.tid < 256) { const int b = F.tid >> 6, c = F.tid & 63; float s = b_ada[cb * 64 + c];
#pragma unroll
              for (int w = 0; w < 8; ++w) s += red[(w * 4 + b) * 64 + c];
              mod[b * 12288 + cb * 64 + c] = s; }
          __syncthreads(); } }
}

__device__ __forceinline__ void route_token(const Args& A, unsigned* ctl, int token);
template <int NT, bool ROUTE>
__device__ __forceinline__ void norm_rows_skinny(Frame& F, const Args& A, const float* xin, const float* gvec, const float* modsh, const float* modsc, bf16* Hout, const bf16* WT, float* outS, int ldS) {
    for (int task = F.gw; task < M / 16; task += F.NGW) {
        const int r0 = task * 16, b = r0 >> 12;
        for (int rr = 0; rr < 16; ++rr) {
            const int row = r0 + rr;
            const GAS f32x4* xr = (const GAS f32x4*)(xin + (size_t)row * D) + F.lane;
            f32x4 v[8]; float s = 0.f;
#pragma unroll
            for (int j = 0; j < 8; ++j) { v[j] = xr[64 * j]; s += (v[j].x * v[j].x + v[j].y * v[j].y) + (v[j].z * v[j].z + v[j].w * v[j].w); }
            const float r = rsqrtf(wave_sum(s) * (1.f / D) + EPS);
            GAS v2u* o8 = (GAS v2u*)(Hout + (size_t)row * D) + F.lane;
#pragma unroll
            for (int j = 0; j < 8; ++j) { const int k = 4 * F.lane + 256 * j;
                const f32x4 g4 = *(const f32x4*)(gvec + k), sc4 = *(const f32x4*)(modsc + b * 12288 + k), sh4 = *(const f32x4*)(modsh + b * 12288 + k);
                const f32x4 h = (v[j] * r) * g4 * (sc4 + 1.0f) + sh4;
                v2u w; w.x = pk2(h.x, h.y); w.y = pk2(h.z, h.w); o8[64 * j] = w; }
        }
        VM_WAIT();
        pg8::f32x4 acc[NT];
#pragma unroll
        for (int t = 0; t < NT; ++t) acc[t] = (pg8::f32x4){0.f, 0.f, 0.f, 0.f};
        const bf16* arow = Hout + (size_t)(r0 + (F.lane & 15)) * D + 8 * (F.lane >> 4);
        const bf16* brow = WT + (size_t)(F.lane & 15) * D + 8 * (F.lane >> 4);
#pragma unroll 4
        for (int s = 0; s < 64; ++s) { const bf16x8 a = *(const GAS bf16x8*)(arow + 32 * s);
#pragma unroll
            for (int t = 0; t < NT; ++t) { const bf16x8 bb = *(const GAS bf16x8*)(brow + (size_t)t * 16 * D + 32 * s);
                acc[t] = __builtin_amdgcn_mfma_f32_16x16x32_bf16(a, bb, acc[t], 0, 0, 0); } }
#pragma unroll
        for (int t = 0; t < NT; ++t)
#pragma unroll
            for (int rg = 0; rg < 4; ++rg) outS[(size_t)(r0 + 4 * (F.lane >> 4) + rg) * ldS + 16 * t + (F.lane & 15)] = acc[t][rg];
        if constexpr (ROUTE) { VM_WAIT(); if (F.lane < 16) route_token(A, F.ctl, r0 + F.lane); }
    }
}

__device__ __forceinline__ void p3_cumf(Frame& F, const Args& A) {
    const float* small = (const float*)(ARG_WS + WS_SMALL); float* cumf = (float*)(ARG_WS + WS_CUMF); const float* fbias = ARG_IN(10);
    LAS float* red = (LAS float*)F.lds;
    for (int bh = F.vcu; bh < BATCH * NH; bh += F.G) { const int b = bh >> 3, h = bh & 7; const float fb = fbias[h];
        float v[8]; float run = 0.f;
#pragma unroll
        for (int i = 0; i < 8; ++i) { const int t = F.tid * 8 + i; run += logsigmoidf_(small[(size_t)(b * SEQ + t) * 32 + 16 + h] + fb); v[i] = run; }
        float inc = run;
#pragma unroll
        for (int o = 1; o < 64; o <<= 1) { const float t_ = __shfl_up(inc, o); if (F.lane >= o) inc += t_; }
        if (F.lane == 63) red[F.wave] = inc;
        LDS_WAIT(); __syncthreads();
        float base = inc - run;
        for (int w = 0; w < F.wave; ++w) base += red[w];
#pragma unroll
        for (int i = 0; i < 8; ++i) cumf[(size_t)bh * SEQ + F.tid * 8 + i] = -(base + v[i]) * 11.313708498984761f;
        __syncthreads();
    }
}

__device__ __forceinline__ fa::BlockRef<fa::TIN, fa::TOUT> fa_ref(const Args& A, int bh, int qb) {
    const fa::TIN* QB = (const fa::TIN*)(ARG_WS + WS_QKVB); const fa::TIN* KB = QB + QKVB_STRIDE; const fa::TIN* VB = KB + QKVB_STRIDE;
    fa::BlockRef<fa::TIN, fa::TOUT> r; const int b = bh >> 3, h = bh & 7;
    r.Q = QB + ((size_t)bh * SEQ + (size_t)qb * fa::QB) * HD; r.K = KB + (size_t)bh * SEQ * HD; r.V = VB + (size_t)bh * SEQ * HD;
    r.FB = (const float*)(ARG_WS + WS_CUMF) + (size_t)bh * SEQ;
    r.O = (fa::TOUT*)(ARG_WS + WS_H) + ((size_t)b * SEQ + (size_t)qb * fa::QB) * D + 1024 + h * HD; r.P0 = qb * fa::QB;
    return r;
}
__device__ __forceinline__ void p4_attn(Frame& F, const Args& A, char* lds) {
    constexpr int NQB = SEQ / fa::QB, NX = NQB / 2, TOTAL = BATCH * NH * NX;
    int L = F.vcu; if (L >= TOTAL) return;
    int bh = L / NX, x = L % NX, pass = 0;
    fa::BlockRef<fa::TIN, fa::TOUT> cur = fa_ref(A, bh, x);
    fa::Seam<fa::TIN> S;
    fa::causal_swa_prime<fa::TIN, fa::TOUT>(cur, fa::WINDOW, lds, S);
    for (;;) {
        const bool more_pass = pass == 0, more_item = L + F.G < TOTAL, last = !more_pass && !more_item;
        int bhn = bh, xn = x, passn = pass + 1, Ln = L;
        if (!more_pass) { passn = 0; Ln = more_item ? L + F.G : L; bhn = Ln / NX; xn = Ln % NX; }
        const fa::BlockRef<fa::TIN, fa::TOUT> nxt = last ? cur : fa_ref(A, bhn, passn ? NQB - 1 - xn : xn);
        fa::causal_swa_block<fa::TIN, fa::TOUT>(cur, nxt, SEQ, fa::WINDOW, lds, S);
        if (last) break;
        cur = nxt; bh = bhn; x = xn; pass = passn; L = Ln;
    }
}

__device__ __forceinline__ void route_token(const Args& A, unsigned* ctl, int token) {
    const float* rl = (const float*)(ARG_WS + WS_RL) + (size_t)token * 48; const float* b_rg = ARG_IN(14); const float* b_re = ARG_IN(16);
    float gl[4]; int gi = 0;
#pragma unroll
    for (int g = 0; g < 4; ++g) { gl[g] = rl[g] + b_rg[g]; }
#pragma unroll
    for (int g = 1; g < 4; ++g) if (gl[g] > gl[gi]) gi = g;
    float gs = 0.f;
#pragma unroll
    for (int g = 0; g < 4; ++g) gs += __expf(gl[g] - gl[gi]);
    const float pg = 1.f / gs;
    float el[8];
#pragma unroll
    for (int e = 0; e < 8; ++e) el[e] = rl[4 + gi * 8 + e] + b_re[gi * 8 + e];
    int i0 = 0;
#pragma unroll
    for (int e = 1; e < 8; ++e) if (el[e] > el[i0]) i0 = e;
    int i1 = (i0 == 0) ? 1 : 0;
#pragma unroll
    for (int e = 0; e < 8; ++e) if (e != i0 && el[e] > el[i1]) i1 = e;
    const float e1 = __expf(el[i1] - el[i0]); const float w0 = pg / (1.f + e1), w1 = pg * e1 / (1.f + e1);
    int* toke = (int*)(ARG_WS + WS_ROUTE + RT_TOKE); float* tokw = (float*)(ARG_WS + WS_ROUTE + RT_TOKW); int* tokr = (int*)(ARG_WS + WS_ROUTE + RT_TOKR);
    const int ge0 = gi * 8 + i0, ge1 = gi * 8 + i1;
    toke[token * 2] = ge0; toke[token * 2 + 1] = ge1; tokw[token * 2] = w0; tokw[token * 2 + 1] = w1;
    tokr[token * 2] = (int)atomicAdd(ctl + CW_CNT + 64 * ge0, 1u); tokr[token * 2 + 1] = (int)atomicAdd(ctl + CW_CNT + 64 * ge1, 1u);
}
__device__ __forceinline__ void expert_offsets(Frame& F, LAS int* off) {
    if (F.tid == 0) { int run = 0; for (int e = 0; e < NE; ++e) { off[e] = run; const int c = (int)__hip_atomic_load(F.ctl + CW_CNT + 64 * e, RLX_AGENT); off[NE + 1 + e] = c; run += (c + 255) & ~255; } off[NE] = run; }
    LDS_WAIT(); __syncthreads();
}
__device__ __forceinline__ void p8_slots(Frame& F, const Args& A) {
    LAS int* off = (LAS int*)F.lds; expert_offsets(F, off);
    const int* toke = (const int*)(ARG_WS + WS_ROUTE + RT_TOKE); const float* tokw = (const float*)(ARG_WS + WS_ROUTE + RT_TOKW); int* tokr = (int*)(ARG_WS + WS_ROUTE + RT_TOKR);
    int* list = (int*)(ARG_WS + WS_ROUTE + RT_LIST); float* slotw = (float*)(ARG_WS + WS_ROUTE + RT_SLOTW);
    const int gt = F.vcu * NTHR + F.tid, NT_ = F.G * NTHR;
    for (int i = gt; i < M * 2; i += NT_) { const int e = toke[i]; const int slot = off[e] + tokr[i]; tokr[i] = slot; list[slot] = i >> 1; slotw[slot] = tokw[i]; }
    const int total = off[NE];
    for (int s = gt; s < total; s += NT_) { int e = 0;
        for (int k = 1; k < NE; ++k) if (s >= off[k]) e = k;
        if (s - off[e] >= off[NE + 1 + e]) { list[s] = -1; slotw[s] = 0.f; } }
    if (F.vcu == 0) { int* tile_e = (int*)(ARG_WS + WS_ROUTE + RT_TILEE);
        for (int t = F.tid; t < 256; t += NTHR) { int e = 0; for (int k = 1; k < NE; ++k) if (t * 256 >= off[k]) e = k; tile_e[t] = (t == 255) ? total / 256 : e; } }
    __syncthreads();
}
struct MoeOrder {
    const int* tile_e; int ntiles, nN, G, c;
    __device__ __forceinline__ bool next(int i, pg8::Unit& u) const { const int L = i * G + c; if (L >= ntiles * nN) return false;
        const int pm = L / nN, pl = L - pm * nN; u.pm = pm; u.pn = tile_e[pm] * nN + pl; return true; }
    __device__ __forceinline__ void a_ready(const pg8::Unit&) const {}
    __device__ __forceinline__ void done(const pg8::Unit&) const {}
};
struct EpiMoeUp {
    static constexpr bool PERM = false, AFTER_DRAIN = false;
    bf16* HID; const float* slotw;
    __device__ __forceinline__ void operator()(const pg8::f32x4 (&acc)[2][2][4][2], const pg8::Unit& u, int wr, int wc, int fr, int fq) const {
        const int slot0 = u.pm * 256 + wr * 64 + fr, col0 = (u.pn & 3) * 128 + wc * 16 + 4 * fq;
#pragma unroll
        for (int ai = 0; ai < 2; ++ai)
#pragma unroll
            for (int m = 0; m < 4; ++m) { const int slot = slot0 + ai * 128 + m * 16; const float w = slotw[slot];
#pragma unroll
                for (int bj = 0; bj < 2; ++bj) { const pg8::f32x4 a = acc[ai][bj][m][0], b = acc[ai][bj][m][1];
                    v2u o; o.x = pg8::cvt_pk_bf16(siluf(a[0]) * b[0] * w, siluf(a[1]) * b[1] * w); o.y = pg8::cvt_pk_bf16(siluf(a[2]) * b[2] * w, siluf(a[3]) * b[3] * w);
                    *(v2u*)(HID + (size_t)slot * DE + col0 + bj * 64) = o; } }
    }
};
struct EpiMoeDown {
    static constexpr bool PERM = true, AFTER_DRAIN = false;
    bf16* Y;
    __device__ __forceinline__ void operator()(const pg8::f32x4 (&acc)[2][2][4][2], const pg8::Unit& u, int wr, int wc, int fr, int fq) const {
        const int row0 = u.pm * 256 + wr * 64 + fr, col0 = (u.pn & 7) * 256 + wc * 32 + 8 * fq;
#pragma unroll
        for (int ai = 0; ai < 2; ++ai)
#pragma unroll
            for (int m = 0; m < 4; ++m) { bf16* rowp = Y + (size_t)(row0 + ai * 128 + m * 16) * D + col0;
#pragma unroll
                for (int bj = 0; bj < 2; ++bj) { const pg8::f32x4 v0 = acc[ai][bj][m][0], v1 = acc[ai][bj][m][1];
                    v4u w; w.x = pg8::cvt_pk_bf16(v0[0], v0[1]); w.y = pg8::cvt_pk_bf16(v0[2], v0[3]); w.z = pg8::cvt_pk_bf16(v1[0], v1[1]); w.w = pg8::cvt_pk_bf16(v1[2], v1[3]);
                    *(v4u*)(rowp + bj * 128) = w; } }
    }
};
__device__ __forceinline__ void p11_final(Frame& F, const Args& A) {
    const float* mod = (const float*)(F.ctl + CW_MOD); const bf16* Y = (const bf16*)(ARG_WS + WS_Y); const int* tokr = (const int*)(ARG_WS + WS_ROUTE + RT_TOKR); const float* fg = ARG_IN(20);
    for (int row = F.gw; row < M; row += F.NGW) { const int b = row >> 12; const int s0 = tokr[row * 2], s1 = tokr[row * 2 + 1];
        GAS f32x4* xr = (GAS f32x4*)(ARG_OUT + (size_t)row * D) + F.lane;
        const GAS v2u* y0 = (const GAS v2u*)(Y + (size_t)s0 * D) + F.lane; const GAS v2u* y1 = (const GAS v2u*)(Y + (size_t)s1 * D) + F.lane;
        f32x4 v[8]; float s = 0.f;
#pragma unroll
        for (int j = 0; j < 8; ++j) { const int k = 4 * F.lane + 256 * j; const f32x4 g2 = *(const f32x4*)(mod + b * 12288 + 5 * D + k);
            const v2u a = y0[64 * j], c = y1[64 * j];
            const f32x4 ys = (f32x4){bflo(a.x) + bflo(c.x), bfhi(a.x) + bfhi(c.x), bflo(a.y) + bflo(c.y), bfhi(a.y) + bfhi(c.y)};
            v[j] = xr[64 * j] + g2 * ys; s += (v[j].x * v[j].x + v[j].y * v[j].y) + (v[j].z * v[j].z + v[j].w * v[j].w); }
        const float r = rsqrtf(wave_sum(s) * (1.f / D) + EPS);
#pragma unroll
        for (int j = 0; j < 8; ++j) { const int k = 4 * F.lane + 256 * j; xr[64 * j] = (v[j] * r) * *(const f32x4*)(fg + k); }
    }
}

constexpr int DN_PN = 272, DN_PT = 144;
constexpr int L_KN = 0, L_QN = 17408, L_XT1 = 34816, L_XT2 = 53248, L_KDT = 71680, L_TN = 90112, L_QK = 99328, L_UT = 108544, L_WT = 126976, L_GT = 145408;
constexpr int L_KSW = 131072;
constexpr size_t WS_GATES = WS_ROUTE + 1 * MiB;
constexpr size_t WS_LASTG = WS_ROUTE + 2 * MiB;
constexpr size_t WS_TBUF = 656 * MiB;
constexpr size_t WS_END2 = 672 * MiB;
#define MFMA16(a, b, c) __builtin_amdgcn_mfma_f32_16x16x32_bf16((a), (b), (c), 0, 0, 0)

__device__ __forceinline__ void conv8(const bf16* QKVA, const float* conv_w, long tok0, int tloc0, int w, int col, float (&y0)[8], float (&y1)[8]) {
    unsigned xw[11];
#pragma unroll
    for (int i = 0; i < 11; ++i) { const int r = 8 * w - 3 + i; xw[i] = (tloc0 + r >= 0) ? *(const unsigned*)(QKVA + (tok0 + r) * CONVCH + col) : 0u; }
    f32x2 cw[4];
#pragma unroll
    for (int j = 0; j < 4; ++j) cw[j] = *(const f32x2*)(conv_w + j * CONVCH + col);
#pragma unroll
    for (int rr = 0; rr < 8; ++rr) { float a0 = 0.f, a1 = 0.f;
#pragma unroll
        for (int j = 0; j < 4; ++j) { a0 += cw[j].x * bflo(xw[rr + j]); a1 += cw[j].y * bfhi(xw[rr + j]); }
        y0[rr] = siluf(a0); y1[rr] = siluf(a1); }
}

__device__ __forceinline__ void dn_prep_solve(Frame& F, const Args& A) {
    const bf16* QKVA = (const bf16*)(ARG_WS + WS_QKVA); const float* small = (const float*)(ARG_WS + WS_SMALL); const float* conv_w = ARG_IN(6);
    float* gates = (float*)(ARG_WS + WS_GATES); float* lastg = (float*)(ARG_WS + WS_LASTG); bf16* TBUF = (bf16*)(ARG_WS + WS_TBUF);
    LAS unsigned char* lds = F.lds; LAS float* gcs = (LAS float*)(lds + LDSCTL_OFF + 1024); LAS float* betas = gcs + 64;
    const int w = F.wave, cp = F.lane, l15 = F.lane & 15, l4 = F.lane >> 4;
    for (int ui = 0; ui < 8; ++ui) { const int unit = F.vcu + F.G * ui; if (unit >= BATCH * NH * NCH) break;
        const int bh = unit >> 6, n = unit & 63, b = bh >> 3, h = bh & 7; const long tok0 = (long)b * SEQ + n * CHUNK;
        if (w == 0) { const float av = small[(tok0 + F.lane) * 32 + h], bv = small[(tok0 + F.lane) * 32 + 8 + h];
            float gc = -__expf(ARG_IN(7)[h]) * softplusf_(av + ARG_IN(8)[h]); const float beta = sigmoidf_(bv);
#pragma unroll
            for (int o = 1; o < 64; o <<= 1) { const float t_ = __shfl_up(gc, o); if (F.lane >= o) gc += t_; }
            gcs[F.lane] = gc; betas[F.lane] = beta; gates[unit * 128 + F.lane] = gc; gates[unit * 128 + 64 + F.lane] = beta; if (F.lane == 63) lastg[unit] = __expf(gc); }
        { float y0[8], y1[8]; conv8(QKVA, conv_w, tok0, n * CHUNK, w, 1024 + h * HD + 2 * cp, y0, y1);
#pragma unroll
          for (int rr = 0; rr < 8; ++rr) { const float rk = rsqrtf(wave_sum(y0[rr] * y0[rr] + y1[rr] * y1[rr]) + EPS); const int r = 8 * w + rr;
              *(LAS unsigned*)(lds + L_KSW + r * 256 + (((cp >> 2) ^ (r & 7)) << 4) + (cp & 3) * 4) = pk2(y0[rr] * rk, y1[rr] * rk); } }
        LDS_WAIT(); __syncthreads();
        { const int ib = w >> 1; LAS float* AL = (LAS float*)(lds + ui * 16384);
#pragma unroll
          for (int jj = 0; jj < 2; ++jj) { const int jb = 2 * (w & 1) + jj;
              if (jb <= ib) { pg8::f32x4 acc = (pg8::f32x4){0.f, 0.f, 0.f, 0.f};
#pragma unroll
                  for (int s = 0; s < 4; ++s) { const int ra = 16 * ib + l15, rb = 16 * jb + l15, c = 4 * s + l4;
                      const bf16x8 a = *(const LAS bf16x8*)(lds + L_KSW + ra * 256 + ((c ^ (ra & 7)) << 4)), bb = *(const LAS bf16x8*)(lds + L_KSW + rb * 256 + ((c ^ (rb & 7)) << 4));
                      acc = MFMA16(a, bb, acc); }
                  const int j = 16 * jb + l15; const float gj = gcs[j];
#pragma unroll
                  for (int rg = 0; rg < 4; ++rg) { const int i = 16 * ib + 4 * l4 + rg;
                      AL[i * 64 + j] = (i > j) ? betas[i] * acc[rg] * __expf(gcs[i] - gj) : 0.f; } } } }
        LDS_WAIT(); __syncthreads();
    }
    { const int unit = F.vcu + F.G * w;
      if (unit < BATCH * NH * NCH) { const LAS float* AL = (const LAS float*)(lds + w * 16384); const int c = F.lane;
          float x[64];
#pragma unroll
          for (int i = 0; i < 64; ++i) { float s0 = (i == c) ? 1.f : 0.f, s1 = 0.f;
#pragma unroll
              for (int j4 = 0; j4 < (i + 3) / 4; ++j4) { const f32x4 a = *(const LAS f32x4*)(AL + i * 64 + 4 * j4);
                  if (4 * j4 + 0 < i) s0 -= a.x * x[4 * j4 + 0];
                  if (4 * j4 + 1 < i) s1 -= a.y * x[4 * j4 + 1];
                  if (4 * j4 + 2 < i) s0 -= a.z * x[4 * j4 + 2];
                  if (4 * j4 + 3 < i) s1 -= a.w * x[4 * j4 + 3]; }
              x[i] = s0 + s1; }
          bf16* Tg = TBUF + (size_t)unit * 4096 + c;
#pragma unroll
          for (int i = 0; i < 64; ++i) Tg[i * 64] = (bf16)f2bf(x[i]); } }
    VM_WAIT(); __syncthreads();
}

__device__ __forceinline__ void dn_prep_mats(Frame& F, const Args& A) {
    const bf16* QKVA = (const bf16*)(ARG_WS + WS_QKVA); const float* conv_w = ARG_IN(6); const float* gates = (const float*)(ARG_WS + WS_GATES); const bf16* TBUF = (const bf16*)(ARG_WS + WS_TBUF);
    bf16* MP = (bf16*)(ARG_WS + WS_MP); bf16* NTg = (bf16*)(ARG_WS + WS_NT); bf16* QP = (bf16*)(ARG_WS + WS_QP); bf16* OL = (bf16*)(ARG_WS + WS_OL);
    LAS unsigned char* lds = F.lds; LAS float* gt = (LAS float*)(lds + L_GT);
    const int w = F.wave, cp = F.lane, l15 = F.lane & 15, l4 = F.lane >> 4;
    for (int ui = 0; ui < 8; ++ui) { const int unit = F.vcu + F.G * ui; if (unit >= BATCH * NH * NCH) break;
        const int bh = unit >> 6, n = unit & 63, b = bh >> 3, h = bh & 7; const long tok0 = (long)b * SEQ + n * CHUNK;
        if (F.tid < 64) { const float gc = gates[unit * 128 + F.tid], gl = gates[unit * 128 + 63]; gt[F.tid] = gc; gt[64 + F.tid] = gates[unit * 128 + 64 + F.tid]; gt[128 + F.tid] = __expf(gc); gt[192 + F.tid] = __expf(gl - gc); }
        { const v4u tv = *(const v4u*)(TBUF + (size_t)unit * 4096 + F.tid * 8);
          *(LAS v4u*)(lds + L_TN + (F.tid >> 3) * DN_PT + (F.tid & 7) * 16) = tv; }
        LDS_WAIT(); __syncthreads();
        {
            float q0[8], q1[8], k0[8], k1[8], v0[8], v1[8];
            conv8(QKVA, conv_w, tok0, n * CHUNK, w, h * HD + 2 * cp, q0, q1);
            conv8(QKVA, conv_w, tok0, n * CHUNK, w, 1024 + h * HD + 2 * cp, k0, k1);
            conv8(QKVA, conv_w, tok0, n * CHUNK, w, 2048 + h * HD + 2 * cp, v0, v1);
            unsigned x1a[8], x1b[8], x2a[8], x2b[8], kda[8], kdb[8];
#pragma unroll
            for (int rr = 0; rr < 8; ++rr) { const int r = 8 * w + rr;
                const float rq = rsqrtf(wave_sum(q0[rr] * q0[rr] + q1[rr] * q1[rr]) + EPS) * 0.08838834764831845f, rk = rsqrtf(wave_sum(k0[rr] * k0[rr] + k1[rr] * k1[rr]) + EPS);
                const float be = gt[64 + r], eg = gt[128 + r], ek = gt[192 + r];
                const float ka = k0[rr] * rk, kb = k1[rr] * rk;
                *(LAS unsigned*)(lds + L_QN + r * DN_PN + cp * 4) = pk2(q0[rr] * rq, q1[rr] * rq);
                *(LAS unsigned*)(lds + L_KN + r * DN_PN + cp * 4) = pk2(ka, kb);
                x1a[rr] = f2bf(v0[rr] * be); x1b[rr] = f2bf(v1[rr] * be); x2a[rr] = f2bf(ka * be * eg); x2b[rr] = f2bf(kb * be * eg); kda[rr] = f2bf(ka * ek); kdb[rr] = f2bf(kb * ek); }
#define DN_PACK8(x) (v4u){(x)[0] | ((x)[1] << 16), (x)[2] | ((x)[3] << 16), (x)[4] | ((x)[5] << 16), (x)[6] | ((x)[7] << 16)}
            *(LAS v4u*)(lds + L_XT1 + (2 * cp) * DN_PT + w * 16) = DN_PACK8(x1a); *(LAS v4u*)(lds + L_XT1 + (2 * cp + 1) * DN_PT + w * 16) = DN_PACK8(x1b);
            *(LAS v4u*)(lds + L_XT2 + (2 * cp) * DN_PT + w * 16) = DN_PACK8(x2a); *(LAS v4u*)(lds + L_XT2 + (2 * cp + 1) * DN_PT + w * 16) = DN_PACK8(x2b);
            *(LAS v4u*)(lds + L_KDT + (2 * cp) * DN_PT + w * 16) = DN_PACK8(kda); *(LAS v4u*)(lds + L_KDT + (2 * cp + 1) * DN_PT + w * 16) = DN_PACK8(kdb);
#undef DN_PACK8
        }
        LDS_WAIT(); __syncthreads();
        {
            const int jb = w >> 1;
#pragma unroll
            for (int ii = 0; ii < 2; ++ii) { const int ib = 2 * (w & 1) + ii; pg8::f32x4 acc = (pg8::f32x4){0.f, 0.f, 0.f, 0.f};
                if (ib >= jb) {
#pragma unroll
                    for (int s = 0; s < 4; ++s) { const bf16x8 a = *(const LAS bf16x8*)(lds + L_KN + (16 * jb + l15) * DN_PN + (8 * l4 + 32 * s) * 2), bb = *(const LAS bf16x8*)(lds + L_QN + (16 * ib + l15) * DN_PN + (8 * l4 + 32 * s) * 2);
                        acc = MFMA16(a, bb, acc); } }
                const int i = 16 * ib + l15; const float gi = gt[i]; float o[4];
#pragma unroll
                for (int rg = 0; rg < 4; ++rg) { const int j = 16 * jb + 4 * l4 + rg; o[rg] = (i >= j) ? acc[rg] * __expf(gi - gt[j]) : 0.f; }
                *(LAS v2u*)(lds + L_QK + i * DN_PT + (16 * jb + 4 * l4) * 2) = (v2u){pk2(o[0], o[1]), pk2(o[2], o[3])}; }
            bf16x8 ta[4][2], b1[2], b2[2];
#pragma unroll
            for (int it = 0; it < 4; ++it)
#pragma unroll
                for (int s = 0; s < 2; ++s) ta[it][s] = *(const LAS bf16x8*)(lds + L_TN + (16 * it + l15) * DN_PT + (8 * l4 + 32 * s) * 2);
#pragma unroll
            for (int s = 0; s < 2; ++s) { b1[s] = *(const LAS bf16x8*)(lds + L_XT1 + (16 * w + l15) * DN_PT + (8 * l4 + 32 * s) * 2); b2[s] = *(const LAS bf16x8*)(lds + L_XT2 + (16 * w + l15) * DN_PT + (8 * l4 + 32 * s) * 2); }
#pragma unroll
            for (int it = 0; it < 4; ++it) { pg8::f32x4 au = (pg8::f32x4){0.f, 0.f, 0.f, 0.f}, aw = au;
#pragma unroll
                for (int s = 0; s < 2; ++s) { au = MFMA16(ta[it][s], b1[s], au); aw = MFMA16(ta[it][s], b2[s], aw); }
                *(LAS v2u*)(lds + L_UT + (16 * w + l15) * DN_PT + (16 * it + 4 * l4) * 2) = (v2u){pk2(au[0], au[1]), pk2(au[2], au[3])};
                *(LAS v2u*)(lds + L_WT + (16 * w + l15) * DN_PT + (16 * it + 4 * l4) * 2) = (v2u){pk2(aw[0], aw[1]), pk2(aw[2], aw[3])}; }
        }
        LDS_WAIT(); __syncthreads();
        {
            bf16x8 wa[2], ua[2], ka[2];
#pragma unroll
            for (int s = 0; s < 2; ++s) { wa[s] = *(const LAS bf16x8*)(lds + L_WT + (16 * w + l15) * DN_PT + (8 * l4 + 32 * s) * 2); ua[s] = *(const LAS bf16x8*)(lds + L_UT + (16 * w + l15) * DN_PT + (8 * l4 + 32 * s) * 2);
                ka[s] = *(const LAS bf16x8*)(lds + L_KDT + (16 * w + l15) * DN_PT + (8 * l4 + 32 * s) * 2); }
            bf16* MPu = MP + (size_t)unit * 16384; bf16* NTu = NTg + (size_t)unit * 16384; bf16* QPu = QP + (size_t)unit * 8192; bf16* OLu = OL + (size_t)unit * 8192;
#pragma unroll
            for (int bt = 0; bt < 8; ++bt) {
                bf16x8 kb[2], ub[2];
#pragma unroll
                for (int s = 0; s < 2; ++s) { kb[s] = *(const LAS bf16x8*)(lds + L_KDT + (16 * bt + l15) * DN_PT + (8 * l4 + 32 * s) * 2); ub[s] = *(const LAS bf16x8*)(lds + L_UT + (16 * bt + l15) * DN_PT + (8 * l4 + 32 * s) * 2); }
                pg8::f32x4 am = (pg8::f32x4){0.f, 0.f, 0.f, 0.f}, an = am;
#pragma unroll
                for (int s = 0; s < 2; ++s) { am = MFMA16(wa[s], kb[s], am); an = MFMA16(ka[s], ub[s], an); }
                *(v2u*)(MPu + (16 * bt + l15) * 128 + 16 * w + 4 * l4) = (v2u){pk2(-am[0], -am[1]), pk2(-am[2], -am[3])};
                *(v2u*)(NTu + (16 * bt + l15) * 128 + 16 * w + 4 * l4) = (v2u){pk2(an[0], an[1]), pk2(an[2], an[3])}; }
#pragma unroll
            for (int bt = 0; bt < 4; ++bt) {
                bf16x8 qb[2];
#pragma unroll
                for (int s = 0; s < 2; ++s) qb[s] = *(const LAS bf16x8*)(lds + L_QK + (16 * bt + l15) * DN_PT + (8 * l4 + 32 * s) * 2);
                pg8::f32x4 aq = (pg8::f32x4){0.f, 0.f, 0.f, 0.f}, ao = aq;
#pragma unroll
                for (int s = 0; s < 2; ++s) { aq = MFMA16(wa[s], qb[s], aq); ao = MFMA16(ua[s], qb[s], ao); }
                const int i = 16 * bt + l15; const float eg = gt[128 + i];
                const v2u qv = *(const LAS v2u*)(lds + L_QN + i * DN_PN + (16 * w + 4 * l4) * 2);
                *(v2u*)(QPu + i * 128 + 16 * w + 4 * l4) = (v2u){pk2(bflo(qv.x) * eg - aq[0], bfhi(qv.x) * eg - aq[1]), pk2(bflo(qv.y) * eg - aq[2], bfhi(qv.y) * eg - aq[3])};
                *(v2u*)(OLu + i * 128 + 16 * w + 4 * l4) = (v2u){pk2(ao[0], ao[1]), pk2(ao[2], ao[3])}; }
        }
        LDS_WAIT(); __syncthreads();
    }
}

constexpr int SC_P = 272;
__device__ __forceinline__ void dn_scan(Frame& F, const Args& A) {
    const bf16* MP = (const bf16*)(ARG_WS + WS_MP); const bf16* NTg = (const bf16*)(ARG_WS + WS_NT); const float* lastg = (const float*)(ARG_WS + WS_LASTG); bf16* SB = (bf16*)(ARG_WS + WS_SB);
    LAS unsigned char* lds = F.lds; const int w = F.wave, l15 = F.lane & 15, l4 = F.lane >> 4;
    for (int su = F.vcu; su < BATCH * NH * 4; su += F.G) { const int bh = su >> 2, sl = su & 3;
        pg8::f32x4 acc[2]; acc[0] = (pg8::f32x4){0.f, 0.f, 0.f, 0.f}; acc[1] = acc[0];
        bf16x8 ma[4]; v2u nt[2]; float lastv;
#define SC_LOAD(u_) do { const bf16* mp_ = MP + (size_t)(u_) * 16384 + (16 * w + l15) * 128 + 8 * l4; \
            _Pragma("unroll") for (int s = 0; s < 4; ++s) ma[s] = *(const bf16x8*)(mp_ + 32 * s); \
            _Pragma("unroll") for (int t = 0; t < 2; ++t) nt[t] = *(const v2u*)(NTg + (size_t)(u_) * 16384 + (32 * sl + 16 * t + l15) * 128 + 16 * w + 4 * l4); \
            lastv = lastg[(u_)]; } while (0)
        SC_LOAD(bh * 64);
        for (int n = 0; n < NCH; ++n) { const int u = bh * 64 + n; LAS unsigned char* st = lds + (n & 1) * (32 * SC_P);
#pragma unroll
            for (int t = 0; t < 2; ++t) { const v2u sv = (v2u){pk2(acc[t][0], acc[t][1]), pk2(acc[t][2], acc[t][3])};
                *(LAS v2u*)(st + (16 * t + l15) * SC_P + (16 * w + 4 * l4) * 2) = sv;
                *(v2u*)(SB + (size_t)u * 16384 + (32 * sl + 16 * t + l15) * 128 + 16 * w + 4 * l4) = sv; }
            bf16x8 mc[4]; v2u nc[2]; const float lc = lastv;
#pragma unroll
            for (int s = 0; s < 4; ++s) mc[s] = ma[s];
            nc[0] = nt[0]; nc[1] = nt[1];
            if (n + 1 < NCH) SC_LOAD(u + 1);
            LDS_WAIT(); __syncthreads();
#pragma unroll
            for (int t = 0; t < 2; ++t) { acc[t] = (pg8::f32x4){acc[t][0] * lc + bflo(nc[t].x), acc[t][1] * lc + bfhi(nc[t].x), acc[t][2] * lc + bflo(nc[t].y), acc[t][3] * lc + bfhi(nc[t].y)};
#pragma unroll
                for (int s = 0; s < 4; ++s) { const bf16x8 sb = *(const LAS bf16x8*)(st + (16 * t + l15) * SC_P + (8 * l4 + 32 * s) * 2); acc[t] = MFMA16(mc[s], sb, acc[t]); } }
        }
#undef SC_LOAD
        __syncthreads();
    }
}

__device__ __forceinline__ void dn_out(Frame& F, const Args& A) {
    const bf16* SB = (const bf16*)(ARG_WS + WS_SB); const bf16* QP = (const bf16*)(ARG_WS + WS_QP); const bf16* OL = (const bf16*)(ARG_WS + WS_OL); const bf16* Z = (const bf16*)(ARG_WS + WS_Z);
    const float* onorm = ARG_IN(9); bf16* MIX = (bf16*)(ARG_WS + WS_H);
    LAS float* part = (LAS float*)F.lds;
    const int w = F.wave, l15 = F.lane & 15, l4 = F.lane >> 4;
    for (int ui = 0; ui < 8; ++ui) { const int unit = F.vcu + F.G * ui; if (unit >= BATCH * NH * NCH) break;
        const int bh = unit >> 6, n = unit & 63, b = bh >> 3, h = bh & 7; const long tok0 = (long)b * SEQ + n * CHUNK;
        bf16x8 sa[4];
#pragma unroll
        for (int s = 0; s < 4; ++s) sa[s] = *(const bf16x8*)(SB + (size_t)unit * 16384 + (16 * w + l15) * 128 + 8 * l4 + 32 * s);
        pg8::f32x4 o[4]; float ss[4];
#pragma unroll
        for (int it = 0; it < 4; ++it) { pg8::f32x4 acc = (pg8::f32x4){0.f, 0.f, 0.f, 0.f};
#pragma unroll
            for (int s = 0; s < 4; ++s) { const bf16x8 qb = *(const bf16x8*)(QP + (size_t)unit * 8192 + (16 * it + l15) * 128 + 8 * l4 + 32 * s); acc = MFMA16(sa[s], qb, acc); }
            const v2u ol = *(const v2u*)(OL + (size_t)unit * 8192 + (16 * it + l15) * 128 + 16 * w + 4 * l4);
            acc = (pg8::f32x4){acc[0] + bflo(ol.x), acc[1] + bfhi(ol.x), acc[2] + bflo(ol.y), acc[3] + bfhi(ol.y)};
            o[it] = acc; float s2 = (acc[0] * acc[0] + acc[1] * acc[1]) + (acc[2] * acc[2] + acc[3] * acc[3]);
            s2 += __shfl_xor(s2, 16); s2 += __shfl_xor(s2, 32); ss[it] = s2; }
        if (l4 == 0) {
#pragma unroll
            for (int it = 0; it < 4; ++it) part[w * 64 + 16 * it + l15] = ss[it]; }
        LDS_WAIT(); __syncthreads();
        const f32x4 gn = *(const f32x4*)(onorm + 16 * w + 4 * l4);
#pragma unroll
        for (int it = 0; it < 4; ++it) { const int i = 16 * it + l15; float tot = 0.f;
#pragma unroll
            for (int ww = 0; ww < 8; ++ww) tot += part[ww * 64 + i];
            const float rn = rsqrtf(tot * (1.f / HD) + EPS);
            const v2u zv = *(const v2u*)(Z + (tok0 + i) * 1024 + h * HD + 16 * w + 4 * l4);
            const float r0 = o[it][0] * rn * gn.x * siluf(bflo(zv.x)), r1 = o[it][1] * rn * gn.y * siluf(bfhi(zv.x)), r2 = o[it][2] * rn * gn.z * siluf(bflo(zv.y)), r3 = o[it][3] * rn * gn.w * siluf(bfhi(zv.y));
            *(v2u*)(MIX + (tok0 + i) * D + h * HD + 16 * w + 4 * l4) = (v2u){pk2(r0, r1), pk2(r2, r3)}; }
        __syncthreads();
    }
}

#define IN(k) (lo <= (k) && (k) < hi)
__global__ void __launch_bounds__(NTHR, 2) fwd(Args args) {
    extern __shared__ __attribute__((aligned(16))) unsigned char lds[];
    Frame F;
    F.lds = (LAS unsigned char*)lds; F.MISC = (volatile LAS unsigned*)(F.lds + MISC_OFF);
    F.tid = threadIdx.x; F.lane = F.tid & 63; F.wave = __builtin_amdgcn_readfirstlane(F.tid >> 6);
    F.G = gridDim.x; { const int bx = blockIdx.x; F.vcu = (F.G % 8 == 0) ? (bx % 8) * (F.G / 8) + bx / 8 : bx; }
    F.gw = F.vcu * NWAVES + F.wave; F.NGW = F.G * NWAVES;
    F.ctl = (unsigned*)(ARG_WS + WS_CTL);
    for (int u = F.tid; u < (LDS_BYTES - LDSCTL_OFF) / 4; u += NTHR) ((LAS unsigned*)(F.lds + LDSCTL_OFF))[u] = 0u;
    __syncthreads();
    const int lo = args.ph_lo, hi = args.ph_hi;
    XcdBarrier bar; bar.bar = F.ctl + CW_BAR; bar.x = 0; bar.st = nullptr;
    if (hi - lo > 1) bar = xcd_barrier_post(F.ctl + CW_BAR, F.MISC + 8);
#define SEAM(k) do { if (IN(k) && hi > (k) + 1) xcd_barrier(bar); } while (0)
    unsigned char* ws = ARG_WS;
    const float* mod = (const float*)(F.ctl + CW_MOD);

    if (IN(0)) { p0_prologue(F, args); SEAM(0); }
    if (IN(1)) { norm_rows_skinny<2, false>(F, args, ARG_IN(0), ARG_IN(4), mod, mod + D, (bf16*)(ws + WS_H), (const bf16*)(ws + WS_WST), (float*)(ws + WS_SMALL), 32); SEAM(1); }
    if (IN(2)) {
        pg8::Gemm g{(const pg8::bf16_t*)(ws + WS_H), (const pg8::bf16_t*)(ws + WS_WINT), M, NBIG, D}; pg8::StaticOrder S; S.init(M, NBIG, F.G, (int)blockIdx.x);
        EpiProj E{(bf16*)(ws + WS_QKVA), (bf16*)(ws + WS_Z), (bf16*)(ws + WS_QKVB)};
        pg8::gemm_phase<EpiProj, pg8::StaticOrder, true, true>(F.lds, g, S, E);
        SEAM(2); }
    if (IN(3)) { p3_cumf(F, args); __syncthreads(); dn_prep_solve(F, args); dn_prep_mats(F, args); SEAM(3); }
    if (IN(4)) { dn_scan(F, args); SEAM(4); }
    if (IN(5)) { p4_attn(F, args, (char*)lds); __syncthreads(); dn_out(F, args); SEAM(5); }
    if (IN(6)) {
        pg8::Gemm g{(const pg8::bf16_t*)(ws + WS_H), (const pg8::bf16_t*)(ws + WS_WOUTT), M, D, D}; pg8::StaticOrder S; S.init(M, D, F.G, (int)blockIdx.x);
        EpiMix E{ARG_IN(0), mod, ARG_OUT};
        pg8::gemm_phase<EpiMix, pg8::StaticOrder, true, true>(F.lds, g, S, E);
        SEAM(6); }
    if (IN(7)) { norm_rows_skinny<3, true>(F, args, ARG_OUT, ARG_IN(12), mod + 3 * D, mod + 4 * D, (bf16*)(ws + WS_H), (const bf16*)(ws + WS_WRT), (float*)(ws + WS_RL), 48); SEAM(7); }
    if (IN(8)) { p8_slots(F, args); SEAM(8); }
    if (IN(9)) {
        const int* tile_e = (const int*)(ws + WS_ROUTE + RT_TILEE);
        pg8::Gemm g{(const pg8::bf16_t*)(ws + WS_H), (const pg8::bf16_t*)(ws + WS_W13T), SLOT_CAP, NE * 1024, D};
        MoeOrder S{tile_e, tile_e[255], 4, F.G, F.vcu};
        EpiMoeUp E{(bf16*)(ws + WS_HID), (const float*)(ws + WS_ROUTE + RT_SLOTW)};
        pg8::gemm_phase_g<EpiMoeUp, MoeOrder, true, true>(F.lds, g, S, E, (const int*)(ws + WS_ROUTE + RT_LIST));
        SEAM(9); }
    if (IN(10)) {
        const int* tile_e = (const int*)(ws + WS_ROUTE + RT_TILEE);
        pg8::Gemm g{(const pg8::bf16_t*)(ws + WS_HID), (const pg8::bf16_t*)(ws + WS_W2T), SLOT_CAP, NE * D, DE};
        MoeOrder S{tile_e, tile_e[255], 8, F.G, F.vcu};
        EpiMoeDown E{(bf16*)(ws + WS_Y)};
        pg8::gemm_phase<EpiMoeDown, MoeOrder, true, true>(F.lds, g, S, E);
        SEAM(10); }
    if (IN(11)) { p11_final(F, args); }
}
constexpr int NPHASE = 12;

extern "C" void kernel_launch(void* const* d_in, const int* in_sizes, int n_in, void* d_out, int out_size, void* d_ws, size_t ws_size, hipStream_t stream) {
    static int grid = 0;
    if (grid == 0) {
        if (n_in != 21 || out_size != M * D || ws_size < WS_END2) { fprintf(stderr, "kernel_launch: unexpected shapes (n_in %d out %d ws %zu)\n", n_in, out_size, ws_size); grid = -1; return; }
        int dev = 0, cus = 0;
        if (hipGetDevice(&dev) != hipSuccess || hipDeviceGetAttribute(&cus, hipDeviceAttributeMultiprocessorCount, dev) != hipSuccess) { grid = -1; return; }
        if (hipFuncSetAttribute((const void*)fwd, hipFuncAttributeMaxDynamicSharedMemorySize, LDS_BYTES) != hipSuccess) { fprintf(stderr, "kernel_launch: hipFuncSetAttribute failed\n"); grid = -1; return; }
        int per_cu = 0; (void)hipOccupancyMaxActiveBlocksPerMultiprocessor(&per_cu, (const void*)fwd, NTHR, LDS_BYTES); (void)hipGetLastError();
        grid = cus;
    }
    if (grid < 0) return;
    if (hipMemsetAsync((char*)d_ws + WS_CTL, 0, CTL_ZERO_BYTES, stream) != hipSuccess) return;
    Args a{};
    for (int i = 0; i < 21; ++i) a.in[i] = (const float*)d_in[i];
    a.out = (float*)d_out; a.ws = (unsigned char*)d_ws;
#if 0
    for (int p = 0; p < NPHASE; ++p) { a.ph_lo = p; a.ph_hi = p + 1; hipLaunchKernelGGL(fwd, dim3(grid), dim3(NTHR), LDS_BYTES, stream, a); }
#else
    a.ph_lo = 0; a.ph_hi = NPHASE; hipLaunchKernelGGL(fwd, dim3(grid), dim3(NTHR), LDS_BYTES, stream, a);
#endif
}
```

```cpp
#include <hip/hip_runtime.h>
#include <cstdio>
#include <cstdint>
namespace pg8 {
#define PG8_LAS __attribute__((address_space(3)))
typedef unsigned short bf16_t;
typedef short bf16x8 __attribute__((ext_vector_type(8)));
typedef float f32x4 __attribute__((ext_vector_type(4)));
typedef unsigned u32x4 __attribute__((ext_vector_type(4)));
constexpr int BM = 256, BK = 64, HALF = 128, HTB = HALF * BK * 2  , STAGE_BYTES = 8 * HTB, NXCD = 8, WGM = 8;

__host__ __device__ __forceinline__ int lds_byte(int r, int c) { const int st = (r >> 4) * 2 + (c >> 5), rr = r & 15, cc = c & 31, ob = rr * 64 + cc * 2; return st * 1024 + (ob ^ (((ob >> 9) & 1) << 5)); }
__host__ __device__ __forceinline__ void stage_rc(int b, int& R, int& C) { const int st = b / 1024, sb = b % 1024, swz = sb ^ (((sb >> 9) & 1) << 5); R = (st >> 1) * 16 + swz / 64; C = (st & 1) * 32 + (swz % 64) / 2; }
__host__ __device__ __forceinline__ int perm32(int rho) { const int n = rho >> 4, i = rho & 15; return 8 * (i >> 2) + 4 * n + (i & 3); }

struct Unit { int pm, pn; };
struct Gemm { const bf16_t* A; const bf16_t* Bt; int M, N, K; };

struct StaticOrder {
    int nM, nN, nwg, G, c;
    __host__ __device__ void init(int M, int N, int G_, int c_) { nM = M / BM; nN = N / BM; nwg = nM * nN; G = G_; c = c_; }
    __host__ __device__ bool next(int i, Unit& u) const {
        const long L = (long)i * G + c; if (L >= nwg) return false;
        int wgid = (int)L; { const int q = nwg / NXCD, r = nwg % NXCD, xcd = wgid % NXCD, off = wgid / NXCD; wgid = (xcd < r ? xcd * (q + 1) : r * (q + 1) + (xcd - r) * q) + off; }
        const int nig = WGM * nN, gid = wgid / nig, fm = gid * WGM, gsz = (nM - fm) < WGM ? (nM - fm) : WGM;
        u.pm = fm + ((wgid % nig) % gsz); u.pn = (wgid % nig) / gsz; return true;
    }
    __device__ __forceinline__ void a_ready(const Unit&) const {}
    __device__ __forceinline__ void done(const Unit&) const {}
};
__device__ __forceinline__ unsigned cvt_pk_bf16(float lo, float hi) { unsigned r; asm volatile("v_cvt_pk_bf16_f32 %0, %1, %2" : "=v"(r) : "v"(lo), "v"(hi)); return r; }
typedef unsigned u32x2 __attribute__((ext_vector_type(2)));
template <class Epi, class Sched, bool ALIGN_EPI = false, bool SP2 = false>
__device__ __forceinline__ void gemm_phase(PG8_LAS unsigned char* lds, const Gemm g, const Sched& S, const Epi& E) {
    const int tid = threadIdx.x, wid = __builtin_amdgcn_readfirstlane(tid >> 6), lane = tid & 63, wr = wid >> 2, wc = wid & 3, fr = lane & 15, fq = lane >> 4;
    const int K = g.K, nt = K / BK;
    unsigned voffA[2], voffB[2];
#pragma unroll
    for (int i = 0; i < 2; ++i) { int R, C; stage_rc(tid * 16 + i * 8192, R, C); const int Rb = Epi::PERM ? ((R & ~31) + perm32(R & 31)) : R;
        voffA[i] = (unsigned)(R * K + C) * 2u; voffB[i] = (unsigned)(Rb * K + C) * 2u; }
    const size_t kstep = (size_t)(BK * 2);
    const size_t hstep = (size_t)HALF * K * 2;
    const size_t tstep = 2 * hstep;
    const unsigned ldsw = (unsigned)wid * 1024u;
    const int aoff = lds_byte(wr * 64 + fr, fq * 8), boff = lds_byte(wc * 32 + fr, fq * 8);
#define PG8_SA(b, h) (((b) * 2 + (h)) * HTB)
#define PG8_SB(b, h) ((4 + (b) * 2 + (h)) * HTB)
#define PG8_STAGE(bufoff, gbase, voff) do { _Pragma("unroll") for (int _i = 0; _i < 2; ++_i) \
        __builtin_amdgcn_global_load_lds((const unsigned*)((const char*)(gbase) + (voff)[_i]), (PG8_LAS unsigned*)(lds + (bufoff) + ldsw + _i * 8192), 16, 0, 0); } while (0)
#define PG8_LDA(dst, b, h) do { _Pragma("unroll") for (int m = 0; m < 4; ++m) _Pragma("unroll") for (int k = 0; k < 2; ++k) dst[m][k] = *(const PG8_LAS bf16x8*)(lds + PG8_SA(b, h) + aoff + m * 2048 + k * 1024); } while (0)
#define PG8_LDB(dst, b, h) do { _Pragma("unroll") for (int n = 0; n < 2; ++n) _Pragma("unroll") for (int k = 0; k < 2; ++k) dst[n][k] = *(const PG8_LAS bf16x8*)(lds + PG8_SB(b, h) + boff + n * 2048 + k * 1024); } while (0)
#define PG8_MMA(ai, bj, At, Bt) do { __builtin_amdgcn_s_setprio(1); _Pragma("unroll") for (int m = 0; m < 4; ++m) _Pragma("unroll") for (int n = 0; n < 2; ++n) _Pragma("unroll") for (int k = 0; k < 2; ++k) \
        acc[ai][bj][m][n] = __builtin_amdgcn_mfma_f32_16x16x32_bf16(Bt[n][k], At[m][k], acc[ai][bj][m][n], 0, 0, 0); __builtin_amdgcn_s_setprio(0); } while (0)
#define PG8_WAIT_V(n) asm volatile("s_waitcnt vmcnt(" #n ")" ::: "memory")
#define PG8_WAIT_L(n) asm volatile("s_waitcnt lgkmcnt(" #n ")" ::: "memory")
#define PG8_BAR __builtin_amdgcn_s_barrier()
#define PG8_SCHED __builtin_amdgcn_sched_barrier(0)
    Unit cur, nxt; int ui = 0;
    if (!S.next(0, cur)) return;
    f32x4 acc[2][2][4][2];
#pragma unroll
    for (int a = 0; a < 2; ++a)
#pragma unroll
        for (int b = 0; b < 2; ++b)
#pragma unroll
            for (int m = 0; m < 4; ++m)
#pragma unroll
                for (int n = 0; n < 2; ++n) acc[a][b][m][n] = (f32x4){0.f, 0.f, 0.f, 0.f};
    bf16x8 At[4][2], B0[2][2], B1[2][2];
    const char* cA = (const char*)g.A + (size_t)cur.pm * tstep; const char* cB = (const char*)g.Bt + (size_t)cur.pn * tstep;
    S.a_ready(cur);
    if constexpr (SP2) {
        PG8_STAGE(PG8_SB(0, 0), cB, voffB); PG8_STAGE(PG8_SB(0, 1), cB + hstep, voffB); PG8_STAGE(PG8_SA(0, 0), cA, voffA); PG8_STAGE(PG8_SA(0, 1), cA + hstep, voffA);
        if (wr == 1) PG8_BAR;
        PG8_WAIT_V(2); PG8_BAR;
        PG8_STAGE(PG8_SB(1, 0), cB + kstep, voffB); PG8_STAGE(PG8_SA(1, 0), cA + kstep, voffA); PG8_STAGE(PG8_SB(1, 1), cB + hstep + kstep, voffB);
        PG8_WAIT_V(6); PG8_BAR;
    } else {
        PG8_STAGE(PG8_SB(0, 0), cB, voffB); PG8_STAGE(PG8_SA(0, 0), cA, voffA); PG8_STAGE(PG8_SB(0, 1), cB + hstep, voffB); PG8_STAGE(PG8_SA(0, 1), cA + hstep, voffA);
        if (wr == 1) PG8_BAR;
        PG8_WAIT_V(4); PG8_BAR;
        PG8_STAGE(PG8_SB(1, 0), cB + kstep, voffB); PG8_STAGE(PG8_SA(1, 0), cA + kstep, voffA); PG8_STAGE(PG8_SB(1, 1), cB + hstep + kstep, voffB);
        PG8_WAIT_V(6); PG8_BAR;
    }
    for (;;) {
        const bool has_next = S.next(ui + 1, nxt);
        const char* nA = has_next ? (const char*)g.A + (size_t)nxt.pm * tstep : cA; const char* nB = has_next ? (const char*)g.Bt + (size_t)nxt.pn * tstep : cB;
        for (int t = 0; t < nt; t += 2) {
            const bool last = (t == nt - 2);
            const char* a1 = cA + (size_t)(t + 1) * kstep;
            const char* a2 = last ? nA : cA + (size_t)(t + 2) * kstep; const char* b2 = last ? nB : cB + (size_t)(t + 2) * kstep;
            const char* a3 = a2 + kstep; const char* b3 = b2 + kstep;
            if (last && has_next) S.a_ready(nxt);
            if constexpr (SP2) {
            PG8_LDB(B0, 0, 0); PG8_LDB(B1, 0, 1); PG8_SCHED; PG8_LDA(At, 0, 0); PG8_STAGE(PG8_SA(1, 1), a1 + hstep, voffA);
            PG8_WAIT_V(8); PG8_WAIT_L(0); PG8_BAR; PG8_MMA(0, 0, At, B0); PG8_MMA(0, 1, At, B1); PG8_BAR; PG8_SCHED;
            PG8_LDA(At, 0, 1); PG8_STAGE(PG8_SB(0, 0), b2, voffB); PG8_STAGE(PG8_SB(0, 1), b2 + hstep, voffB); PG8_STAGE(PG8_SA(0, 0), a2, voffA);
            PG8_WAIT_V(8); PG8_WAIT_L(0); PG8_BAR; PG8_MMA(1, 0, At, B0); PG8_MMA(1, 1, At, B1); PG8_BAR; PG8_SCHED;
            PG8_LDB(B0, 1, 0); PG8_LDB(B1, 1, 1); PG8_SCHED; PG8_LDA(At, 1, 0); PG8_STAGE(PG8_SA(0, 1), a2 + hstep, voffA);
            PG8_WAIT_V(8); PG8_WAIT_L(0); PG8_BAR; PG8_MMA(0, 0, At, B0); PG8_MMA(0, 1, At, B1); PG8_BAR; PG8_SCHED;
            PG8_LDA(At, 1, 1); PG8_STAGE(PG8_SB(1, 0), b3, voffB); PG8_STAGE(PG8_SB(1, 1), b3 + hstep, voffB); PG8_STAGE(PG8_SA(1, 0), a3, voffA);
            PG8_WAIT_V(8); PG8_WAIT_L(0); PG8_BAR; PG8_MMA(1, 0, At, B0); PG8_MMA(1, 1, At, B1); PG8_BAR; PG8_SCHED;
            } else {
            PG8_LDB(B0, 0, 0); PG8_SCHED; PG8_LDA(At, 0, 0); PG8_STAGE(PG8_SA(1, 1), a1 + hstep, voffA);
            PG8_WAIT_L(8); PG8_BAR; PG8_WAIT_L(0); PG8_MMA(0, 0, At, B0); PG8_BAR; PG8_SCHED;
            PG8_LDB(B1, 0, 1); PG8_STAGE(PG8_SB(0, 0), b2, voffB);
            PG8_BAR; PG8_WAIT_L(0); PG8_MMA(0, 1, At, B1); PG8_BAR;
            PG8_LDA(At, 0, 1); PG8_STAGE(PG8_SA(0, 0), a2, voffA);
            PG8_BAR; PG8_WAIT_L(0); PG8_MMA(1, 0, At, B0); PG8_BAR; PG8_SCHED;
            PG8_STAGE(PG8_SB(0, 1), b2 + hstep, voffB);
            PG8_WAIT_V(6); PG8_BAR; PG8_MMA(1, 1, At, B1); PG8_BAR;
            PG8_LDB(B0, 1, 0); PG8_SCHED; PG8_LDA(At, 1, 0); PG8_STAGE(PG8_SA(0, 1), a2 + hstep, voffA);
            PG8_WAIT_L(8); PG8_BAR; PG8_WAIT_L(0); PG8_MMA(0, 0, At, B0); PG8_BAR; PG8_SCHED;
            PG8_LDB(B1, 1, 1); PG8_STAGE(PG8_SB(1, 0), b3, voffB);
            PG8_BAR; PG8_WAIT_L(0); PG8_MMA(0, 1, At, B1); PG8_BAR;
            PG8_LDA(At, 1, 1); PG8_STAGE(PG8_SA(1, 0), a3, voffA);
            PG8_BAR; PG8_WAIT_L(0); PG8_MMA(1, 0, At, B0); PG8_BAR; PG8_SCHED;
            PG8_STAGE(PG8_SB(1, 1), b3 + hstep, voffB);
            PG8_WAIT_V(6); PG8_BAR; PG8_MMA(1, 1, At, B1); PG8_BAR;
            }
        }
        if constexpr (ALIGN_EPI) { if (wr == 0) PG8_BAR; }
        if constexpr (!Epi::AFTER_DRAIN) { E(acc, cur, wr, wc, fr, fq); S.done(cur); }
        if (!has_next) break;
#pragma unroll
        for (int a = 0; a < 2; ++a)
#pragma unroll
            for (int b = 0; b < 2; ++b)
#pragma unroll
                for (int m = 0; m < 4; ++m)
#pragma unroll
                    for (int n = 0; n < 2; ++n) acc[a][b][m][n] = (f32x4){0.f, 0.f, 0.f, 0.f};
        cur = nxt; cA = nA; cB = nB; ++ui;
        if constexpr (ALIGN_EPI) { if (wr == 1) PG8_BAR; }
    }
    PG8_WAIT_V(0);
    if constexpr (!ALIGN_EPI) { if (wr == 0) PG8_BAR; }
    PG8_BAR;
    if constexpr (Epi::AFTER_DRAIN) { E.fused(acc, cur, wr, wc, fr, fq, lds, wid, lane); S.done(cur); }
#undef PG8_SA
#undef PG8_SB
#undef PG8_STAGE
#undef PG8_LDA
#undef PG8_LDB
#undef PG8_MMA
#undef PG8_WAIT_V
#undef PG8_WAIT_L
#undef PG8_BAR
#undef PG8_SCHED
}
template <class Epi, class Sched, bool ALIGN_EPI = false, bool SP2 = false>
__device__ __forceinline__ void gemm_phase_g(PG8_LAS unsigned char* lds, const Gemm g, const Sched& S, const Epi& E, const int* __restrict__ rowlist) {
    const int tid = threadIdx.x, wid = __builtin_amdgcn_readfirstlane(tid >> 6), lane = tid & 63, wr = wid >> 2, wc = wid & 3, fr = lane & 15, fq = lane >> 4;
    const int K = g.K, nt = K / BK;
    unsigned voffB[2]; int RA[2], CA[2];
#pragma unroll
    for (int i = 0; i < 2; ++i) { int R, C; stage_rc(tid * 16 + i * 8192, R, C); const int Rb = Epi::PERM ? ((R & ~31) + perm32(R & 31)) : R;
        RA[i] = R; CA[i] = C * 2; voffB[i] = (unsigned)(Rb * K + C) * 2u; }
    unsigned va[2][2], vn[2][2], vs[2][2];
#define PG8_GATHER(dst, u) do { _Pragma("unroll") for (int h_ = 0; h_ < 2; ++h_) _Pragma("unroll") for (int i_ = 0; i_ < 2; ++i_) { int tk_ = rowlist[(u).pm * BM + h_ * HALF + RA[i_]]; tk_ = tk_ < 0 ? 0 : tk_; dst[h_][i_] = (unsigned)tk_ * (unsigned)(K * 2) + (unsigned)CA[i_]; } } while (0)
    const size_t kstep = (size_t)(BK * 2);
    const size_t hstep = (size_t)HALF * K * 2;
    const size_t tstep = 2 * hstep;
    const unsigned ldsw = (unsigned)wid * 1024u;
    const int aoff = lds_byte(wr * 64 + fr, fq * 8), boff = lds_byte(wc * 32 + fr, fq * 8);
#define PG8_SA(b, h) (((b) * 2 + (h)) * HTB)
#define PG8_SB(b, h) ((4 + (b) * 2 + (h)) * HTB)
#define PG8_STAGE(bufoff, gbase, voff) do { _Pragma("unroll") for (int _i = 0; _i < 2; ++_i) \
        __builtin_amdgcn_global_load_lds((const unsigned*)((const char*)(gbase) + (voff)[_i]), (PG8_LAS unsigned*)(lds + (bufoff) + ldsw + _i * 8192), 16, 0, 0); } while (0)
#define PG8_STAGE_A(bufoff, gbase, OFFS, hh) do { _Pragma("unroll") for (int _i = 0; _i < 2; ++_i) \
        __builtin_amdgcn_global_load_lds((const unsigned*)((const char*)(gbase) + (OFFS)[hh][_i]), (PG8_LAS unsigned*)(lds + (bufoff) + ldsw + _i * 8192), 16, 0, 0); } while (0)
#define PG8_LDA(dst, b, h) do { _Pragma("unroll") for (int m = 0; m < 4; ++m) _Pragma("unroll") for (int k = 0; k < 2; ++k) dst[m][k] = *(const PG8_LAS bf16x8*)(lds + PG8_SA(b, h) + aoff + m * 2048 + k * 1024); } while (0)
#define PG8_LDB(dst, b, h) do { _Pragma("unroll") for (int n = 0; n < 2; ++n) _Pragma("unroll") for (int k = 0; k < 2; ++k) dst[n][k] = *(const PG8_LAS bf16x8*)(lds + PG8_SB(b, h) + boff + n * 2048 + k * 1024); } while (0)
#define PG8_MMA(ai, bj, At, Bt) do { __builtin_amdgcn_s_setprio(1); _Pragma("unroll") for (int m = 0; m < 4; ++m) _Pragma("unroll") for (int n = 0; n < 2; ++n) _Pragma("unroll") for (int k = 0; k < 2; ++k) \
        acc[ai][bj][m][n] = __builtin_amdgcn_mfma_f32_16x16x32_bf16(Bt[n][k], At[m][k], acc[ai][bj][m][n], 0, 0, 0); __builtin_amdgcn_s_setprio(0); } while (0)
#define PG8_WAIT_V(n) asm volatile("s_waitcnt vmcnt(" #n ")" ::: "memory")
#define PG8_WAIT_L(n) asm volatile("s_waitcnt lgkmcnt(" #n ")" ::: "memory")
#define PG8_BAR __builtin_amdgcn_s_barrier()
#define PG8_SCHED __builtin_amdgcn_sched_barrier(0)
    Unit cur, nxt; int ui = 0;
    if (!S.next(0, cur)) return;
    f32x4 acc[2][2][4][2];
#pragma unroll
    for (int a = 0; a < 2; ++a)
#pragma unroll
        for (int b = 0; b < 2; ++b)
#pragma unroll
            for (int m = 0; m < 4; ++m)
#pragma unroll
                for (int n = 0; n < 2; ++n) acc[a][b][m][n] = (f32x4){0.f, 0.f, 0.f, 0.f};
    bf16x8 At[4][2], B0[2][2], B1[2][2];
    const char* cA = (const char*)g.A; const char* cB = (const char*)g.Bt + (size_t)cur.pn * tstep;
    S.a_ready(cur);
    PG8_GATHER(va, cur);
    if constexpr (SP2) {
        PG8_STAGE(PG8_SB(0, 0), cB, voffB); PG8_STAGE(PG8_SB(0, 1), cB + hstep, voffB); PG8_STAGE_A(PG8_SA(0, 0), cA, va, 0); PG8_STAGE_A(PG8_SA(0, 1), cA, va, 1);
        if (wr == 1) PG8_BAR;
        PG8_WAIT_V(2); PG8_BAR;
        PG8_STAGE(PG8_SB(1, 0), cB + kstep, voffB); PG8_STAGE_A(PG8_SA(1, 0), cA + kstep, va, 0); PG8_STAGE(PG8_SB(1, 1), cB + hstep + kstep, voffB);
        PG8_WAIT_V(6); PG8_BAR;
    } else {
        PG8_STAGE(PG8_SB(0, 0), cB, voffB); PG8_STAGE_A(PG8_SA(0, 0), cA, va, 0); PG8_STAGE(PG8_SB(0, 1), cB + hstep, voffB); PG8_STAGE_A(PG8_SA(0, 1), cA, va, 1);
        if (wr == 1) PG8_BAR;
        PG8_WAIT_V(4); PG8_BAR;
        PG8_STAGE(PG8_SB(1, 0), cB + kstep, voffB); PG8_STAGE_A(PG8_SA(1, 0), cA + kstep, va, 0); PG8_STAGE(PG8_SB(1, 1), cB + hstep + kstep, voffB);
        PG8_WAIT_V(6); PG8_BAR;
    }
    for (;;) {
        const bool has_next = S.next(ui + 1, nxt);
        const char* nA = cA; const char* nB = has_next ? (const char*)g.Bt + (size_t)nxt.pn * tstep : cB;
        if (has_next) { PG8_GATHER(vn, nxt); } else { _Pragma("unroll") for (int h_ = 0; h_ < 2; ++h_) _Pragma("unroll") for (int i_ = 0; i_ < 2; ++i_) vn[h_][i_] = va[h_][i_]; }
        for (int t = 0; t < nt; t += 2) {
            const bool last = (t == nt - 2);
            const char* a1 = cA + (size_t)(t + 1) * kstep;
            const char* a2 = last ? nA : cA + (size_t)(t + 2) * kstep; const char* b2 = last ? nB : cB + (size_t)(t + 2) * kstep;
            const char* a3 = a2 + kstep; const char* b3 = b2 + kstep;
            if (last && has_next) S.a_ready(nxt);
#pragma unroll
            for (int h_ = 0; h_ < 2; ++h_)
#pragma unroll
                for (int i_ = 0; i_ < 2; ++i_) vs[h_][i_] = last ? vn[h_][i_] : va[h_][i_];
            if constexpr (SP2) {
            PG8_LDB(B0, 0, 0); PG8_LDB(B1, 0, 1); PG8_SCHED; PG8_LDA(At, 0, 0); PG8_STAGE_A(PG8_SA(1, 1), a1, va, 1);
            PG8_WAIT_V(8); PG8_WAIT_L(0); PG8_BAR; PG8_MMA(0, 0, At, B0); PG8_MMA(0, 1, At, B1); PG8_BAR; PG8_SCHED;
            PG8_LDA(At, 0, 1); PG8_STAGE(PG8_SB(0, 0), b2, voffB); PG8_STAGE(PG8_SB(0, 1), b2 + hstep, voffB); PG8_STAGE_A(PG8_SA(0, 0), a2, vs, 0);
            PG8_WAIT_V(8); PG8_WAIT_L(0); PG8_BAR; PG8_MMA(1, 0, At, B0); PG8_MMA(1, 1, At, B1); PG8_BAR; PG8_SCHED;
            PG8_LDB(B0, 1, 0); PG8_LDB(B1, 1, 1); PG8_SCHED; PG8_LDA(At, 1, 0); PG8_STAGE_A(PG8_SA(0, 1), a2, vs, 1);
            PG8_WAIT_V(8); PG8_WAIT_L(0); PG8_BAR; PG8_MMA(0, 0, At, B0); PG8_MMA(0, 1, At, B1); PG8_BAR; PG8_SCHED;
            PG8_LDA(At, 1, 1); PG8_STAGE(PG8_SB(1, 0), b3, voffB); PG8_STAGE(PG8_SB(1, 1), b3 + hstep, voffB); PG8_STAGE_A(PG8_SA(1, 0), a3, vs, 0);
            PG8_WAIT_V(8); PG8_WAIT_L(0); PG8_BAR; PG8_MMA(1, 0, At, B0); PG8_MMA(1, 1, At, B1); PG8_BAR; PG8_SCHED;
            } else {
            PG8_LDB(B0, 0, 0); PG8_SCHED; PG8_LDA(At, 0, 0); PG8_STAGE_A(PG8_SA(1, 1), a1, va, 1);
            PG8_WAIT_L(8); PG8_BAR; PG8_WAIT_L(0); PG8_MMA(0, 0, At, B0); PG8_BAR; PG8_SCHED;
            PG8_LDB(B1, 0, 1); PG8_STAGE(PG8_SB(0, 0), b2, voffB);
            PG8_BAR; PG8_WAIT_L(0); PG8_MMA(0, 1, At, B1); PG8_BAR;
            PG8_LDA(At, 0, 1); PG8_STAGE_A(PG8_SA(0, 0), a2, vs, 0);
            PG8_BAR; PG8_WAIT_L(0); PG8_MMA(1, 0, At, B0); PG8_BAR; PG8_SCHED;
            PG8_STAGE(PG8_SB(0, 1), b2 + hstep, voffB);
            PG8_WAIT_V(6); PG8_BAR; PG8_MMA(1, 1, At, B1); PG8_BAR;
            PG8_LDB(B0, 1, 0); PG8_SCHED; PG8_LDA(At, 1, 0); PG8_STAGE_A(PG8_SA(0, 1), a2, vs, 1);
            PG8_WAIT_L(8); PG8_BAR; PG8_WAIT_L(0); PG8_MMA(0, 0, At, B0); PG8_BAR; PG8_SCHED;
            PG8_LDB(B1, 1, 1); PG8_STAGE(PG8_SB(1, 0), b3, voffB);
            PG8_BAR; PG8_WAIT_L(0); PG8_MMA(0, 1, At, B1); PG8_BAR;
            PG8_LDA(At, 1, 1); PG8_STAGE_A(PG8_SA(1, 0), a3, vs, 0);
            PG8_BAR; PG8_WAIT_L(0); PG8_MMA(1, 0, At, B0); PG8_BAR; PG8_SCHED;
            PG8_STAGE(PG8_SB(1, 1), b3 + hstep, voffB);
            PG8_WAIT_V(6); PG8_BAR; PG8_MMA(1, 1, At, B1); PG8_BAR;
            }
        }
        if constexpr (ALIGN_EPI) { if (wr == 0) PG8_BAR; }
        if constexpr (!Epi::AFTER_DRAIN) { E(acc, cur, wr, wc, fr, fq); S.done(cur); }
        if (!has_next) break;
#pragma unroll
        for (int a = 0; a < 2; ++a)
#pragma unroll
            for (int b = 0; b < 2; ++b)
#pragma unroll
                for (int m = 0; m < 4; ++m)
#pragma unroll
                    for (int n = 0; n < 2; ++n) acc[a][b][m][n] = (f32x4){0.f, 0.f, 0.f, 0.f};
        cur = nxt; cB = nB; ++ui;
#pragma unroll
        for (int h_ = 0; h_ < 2; ++h_)
#pragma unroll
            for (int i_ = 0; i_ < 2; ++i_) va[h_][i_] = vn[h_][i_];
        if constexpr (ALIGN_EPI) { if (wr == 1) PG8_BAR; }
    }
    PG8_WAIT_V(0);
    if constexpr (!ALIGN_EPI) { if (wr == 0) PG8_BAR; }
    PG8_BAR;
    if constexpr (Epi::AFTER_DRAIN) { E.fused(acc, cur, wr, wc, fr, fq, lds, wid, lane); S.done(cur); }
#undef PG8_SA
#undef PG8_SB
#undef PG8_STAGE
#undef PG8_STAGE_A
#undef PG8_GATHER
#undef PG8_LDA
#undef PG8_LDB
#undef PG8_MMA
#undef PG8_WAIT_V
#undef PG8_WAIT_L
#undef PG8_BAR
#undef PG8_SCHED
}
}

constexpr int NWAVES = 8, NTHR = 512;
constexpr int BATCH = 4, SEQ = 4096, D = 2048, M = BATCH * SEQ;
constexpr int NH = 8, HD = 128;
constexpr int INW = 7192, NBIG = 7168;
constexpr int CONVCH = 3072;
constexpr int NG = 4, EPG = 8, NE = 32, DE = 512;
constexpr float EPS = 1e-6f;
constexpr int CHUNK = 64, NCH = SEQ / CHUNK;
constexpr int SLOT_CAP = 40960;

constexpr size_t MiB = 1u << 20;
constexpr size_t WS_CTL = 0, CTL_ZERO_BYTES = 1 * MiB;
constexpr size_t WS_WST = 1 * MiB;
constexpr size_t WS_WRT = 1 * MiB + 256 * 1024;
constexpr size_t WS_SMALL = 2 * MiB;
constexpr size_t WS_WINT = 4 * MiB;
constexpr size_t WS_WOUTT = 32 * MiB;
constexpr size_t WS_H = 40 * MiB;
constexpr size_t WS_QKVA = 104 * MiB;
constexpr size_t WS_Z = 200 * MiB;
constexpr size_t WS_QKVB = 232 * MiB;
constexpr size_t QKVB_STRIDE = (size_t)M * 1024;
constexpr size_t WS_MP = 40 * MiB;
constexpr size_t WS_SB = 104 * MiB;
constexpr size_t WS_NT = 328 * MiB;
constexpr size_t WS_QP = 392 * MiB;
constexpr size_t WS_OL = 424 * MiB;
constexpr size_t WS_W13T = 456 * MiB;
constexpr size_t WS_W2T = 584 * MiB;
constexpr size_t WS_CUMF = 648 * MiB;
constexpr size_t WS_RL = 649 * MiB;
constexpr size_t WS_ROUTE = 652 * MiB;
constexpr size_t WS_END = 656 * MiB;
constexpr size_t WS_Y = 104 * MiB;
constexpr size_t WS_X1B = 264 * MiB;
constexpr size_t WS_HID = 328 * MiB;
static_assert(WS_Y + (size_t)SLOT_CAP * 2048 * 2 <= WS_X1B && WS_X1B + (size_t)M * 2048 * 2 <= WS_HID && WS_HID + (size_t)SLOT_CAP * 512 * 2 <= WS_W13T, "moe overlays");
constexpr size_t RT_TOKE = 0;
constexpr size_t RT_TOKW = 128 * 1024;
constexpr size_t RT_TOKR = 256 * 1024;
constexpr size_t RT_LIST = 384 * 1024;
constexpr size_t RT_SLOTW = 640 * 1024;
constexpr size_t RT_NMAX = 960 * 1024;
constexpr size_t RT_TILEE = 896 * 1024;
constexpr int CW_TMO = 0, CW_CODE = 1;
constexpr int CW_BAR = 4096;
constexpr int CW_CNT = 8192;
constexpr int CW_NMAX = 8192 + 64 * 48;
constexpr int CW_ATTNQ = 8192 + 64 * 40;
constexpr int CW_MOD = 65536;
static_assert((CW_MOD + 4 * 12288) * 4 <= (int)CTL_ZERO_BYTES, "ctl");

constexpr int RING_BYTES = 147456;
constexpr int LDSCTL_OFF = RING_BYTES, MISC_OFF = LDSCTL_OFF + 320;
constexpr int LDS_BYTES = 163840;

#define GAS __attribute__((address_space(1)))
#define LAS __attribute__((address_space(3)))
typedef unsigned short bf16;
typedef unsigned v4u __attribute__((ext_vector_type(4)));
typedef unsigned v2u __attribute__((ext_vector_type(2)));
typedef float f32x4 __attribute__((ext_vector_type(4)));
typedef float f32x2 __attribute__((ext_vector_type(2)));
typedef short bf16x8 __attribute__((ext_vector_type(8)));
typedef GAS unsigned gu32;
#define RLX_AGENT __ATOMIC_RELAXED, __HIP_MEMORY_SCOPE_AGENT
#define LDS_WAIT() asm volatile("s_waitcnt lgkmcnt(0)" ::: "memory")
#define VM_WAIT() asm volatile("s_waitcnt vmcnt(0)" ::: "memory")
__device__ __forceinline__ unsigned f2bf(float f) { unsigned u = __builtin_bit_cast(unsigned, f); return (u + 0x7fffu + ((u >> 16) & 1u)) >> 16; }
typedef __bf16 bf16x2_t __attribute__((ext_vector_type(2)));
__device__ __forceinline__ unsigned pk2(float lo, float hi) { f32x2 v = {lo, hi}; bf16x2_t r = __builtin_convertvector(v, bf16x2_t); return __builtin_bit_cast(unsigned, r); }
__device__ __forceinline__ float bf2f(unsigned short b) { return __builtin_bit_cast(float, ((unsigned)b) << 16); }
__device__ __forceinline__ float bflo(unsigned w) { return __builtin_bit_cast(float, w << 16); }
__device__ __forceinline__ float bfhi(unsigned w) { return __builtin_bit_cast(float, w & 0xffff0000u); }
template <int CTRL> __device__ __forceinline__ float dpp_add(float x) { const int y = __builtin_amdgcn_update_dpp(0, __builtin_bit_cast(int, x), CTRL, 0xF, 0xF, true); return x + __builtin_bit_cast(float, y); }
__device__ __forceinline__ float wave_sum(float v) {
    v = dpp_add<0xB1>(v); v = dpp_add<0x4E>(v); v = dpp_add<0x141>(v); v = dpp_add<0x140>(v);
    v += __shfl_xor(v, 32);
    v += __shfl_xor(v, 16);
    return v;
}
__device__ __forceinline__ float siluf(float x) { return x * __builtin_amdgcn_rcpf(1.f + __expf(-x)); }
__device__ __forceinline__ float sigmoidf_(float x) { return __builtin_amdgcn_rcpf(1.f + __expf(-x)); }
__device__ __forceinline__ float softplusf_(float x) { return x > 20.f ? x : log1pf(expf(x)); }
__device__ __forceinline__ float logsigmoidf_(float x) { return fminf(x, 0.f) - log1pf(expf(-fabsf(x))); }
#define XB_TMO      128
#define XB_XCNT(j)  (256  + 64 * (j))
#define XB_XSUB(j)  (1280 + 64 * (j))
#define XB_XGEN(j)  (2304 + 64 * (j))
#define XB_TOP      3328
#define XB_TOPGEN   3392
#define XCD_BAR_WORDS 3456
#define XB_SPIN_CAP (1u << 18)
#define XB_TMO      128
#define XB_XCNT(j)  (256  + 64 * (j))
#define XB_XSUB(j)  (1280 + 64 * (j))
#define XB_XGEN(j)  (2304 + 64 * (j))
#define XB_TOP      3328
#define XB_TOPGEN   3392
#define XCD_BAR_WORDS 3456
#define XB_SPIN_CAP (1u << 18)

__device__ __forceinline__ unsigned xb_ld(unsigned* p)              { return __hip_atomic_load(p, __ATOMIC_RELAXED, __HIP_MEMORY_SCOPE_AGENT); }
__device__ __forceinline__ unsigned xb_add(unsigned* p, unsigned v) { return __hip_atomic_fetch_add(p, v, __ATOMIC_RELAXED, __HIP_MEMORY_SCOPE_AGENT); }
__device__ __forceinline__ unsigned xb_xcc_id() { return (unsigned)__builtin_amdgcn_s_getreg((3 << 11) | 20) & 0xFu; }
#define XB_SPIN(cond, bar) do { unsigned _sp = 0; while (cond) { __builtin_amdgcn_s_sleep(1); \
    if ((++_sp & 255u) == 0u) { if (xb_ld(&(bar)[XB_TMO])) break; if (_sp > XB_SPIN_CAP) { atomicAdd(&(bar)[XB_TMO], 1u); break; } } } } while (0)

struct XcdBarrier {
    unsigned* bar; unsigned x;
    volatile LAS unsigned* st;
};

__device__ __forceinline__ XcdBarrier xcd_barrier_post(unsigned* bar, volatile LAS unsigned* st) {
    XcdBarrier b; b.bar = bar; b.x = xb_xcc_id(); b.st = st;
    if (threadIdx.x == 0) (void)xb_add(&bar[XB_XCNT(b.x)], 1u);
    return b;
}
__device__ __forceinline__ void xcd_barrier_complete(unsigned* bar, unsigned x, unsigned& nloc, unsigned& nx) {
    const unsigned G = gridDim.x * gridDim.y * gridDim.z;
    unsigned sum, cnt, mine, sp = 0u;
    for (;;) {
        sum = 0u; cnt = 0u; mine = 0u;
#pragma unroll
        for (unsigned j = 0; j < 16; ++j) { const unsigned c = xb_ld(&bar[XB_XCNT(j)]); sum += c; cnt += (c > 0u) ? 1u : 0u; mine = (j == x) ? c : mine; }
        if (sum == G) break;
        __builtin_amdgcn_s_sleep(1);
        if ((++sp & 255u) == 0u) { if (xb_ld(&bar[XB_TMO])) break; if (sp > XB_SPIN_CAP) { atomicAdd(&bar[XB_TMO], 1u); break; } }
    }
    nloc = mine > 0u ? mine : 1u; nx = cnt > 0u ? cnt : 1u;
}

__device__ __forceinline__ void xcd_barrier(const XcdBarrier& b) {
    asm volatile("s_waitcnt vmcnt(0)" ::: "memory");
    __syncthreads();
    if (threadIdx.x == 0) {
        unsigned* bar = b.bar;
        __builtin_amdgcn_s_waitcnt(0);
        unsigned nloc = b.st[0], nx = b.st[1];
        if (nloc == 0u) { xcd_barrier_complete(bar, b.x, nloc, nx); b.st[0] = nloc; b.st[1] = nx; }
        const unsigned old = xb_add(&bar[XB_XSUB(b.x)], 1u);
        const unsigned gen = old / nloc;
        if (old + 1u == (gen + 1u) * nloc) {
            __builtin_amdgcn_fence(__ATOMIC_RELEASE, "agent");
            asm volatile("s_waitcnt vmcnt(0)" ::: "memory");
            const unsigned og = xb_add(&bar[XB_TOP], 1u);
            const unsigned tg = og / nx;
            if (og + 1u == (tg + 1u) * nx) xb_add(&bar[XB_TOPGEN], 1u);
            else XB_SPIN(xb_ld(&bar[XB_TOPGEN]) == tg, bar);
            __builtin_amdgcn_fence(__ATOMIC_ACQUIRE, "agent");
            xb_add(&bar[XB_XGEN(b.x)], 1u);
            asm volatile("s_waitcnt vmcnt(0)" ::: "memory");
        } else {
            XB_SPIN(xb_ld(&bar[XB_XGEN(b.x)]) == gen, bar);
            __builtin_amdgcn_fence(__ATOMIC_ACQUIRE, "agent");
            asm volatile("s_waitcnt vmcnt(0)" ::: "memory");
        }
    }
    __syncthreads();
}

namespace fa {
using TIN = unsigned short; using TOUT = unsigned short;
constexpr int B = 4, H = 8, HKV = 8, SQ = 4096, SKV = 4096, D = 128, QOFF = 0, WINDOW = SKV;
constexpr float THR = 8.f;
constexpr bool WSKIP = false;
constexpr int OPITCH = 2048;
constexpr float SCALE = 0.08838834764831845f;
constexpr int NW = 8, QBLK = 32, KVBLK = 64, QB = NW * QBLK;
constexpr int SHM_V = KVBLK * D * 2, SHM_K = KVBLK * D * 2;
constexpr int LDS_BYTES = 2 * SHM_V + 2 * SHM_K + NW * 64 * 4;
constexpr int LDS_FB = LDS_BYTES;
typedef short bf16x8 __attribute__((ext_vector_type(8)));
typedef short s16x4 __attribute__((ext_vector_type(4)));
typedef float f32x16 __attribute__((ext_vector_type(16)));
typedef float f32x4 __attribute__((ext_vector_type(4)));
typedef unsigned u32x4 __attribute__((ext_vector_type(4)));
template <class A, class Bt> struct same_t { static constexpr bool v = false; };
template <class A> struct same_t<A, A> { static constexpr bool v = true; };

#define KSWZ(row, colB) ((row) * 256 + ((colB) ^ (((row) & 7) << 4)))
#define SBAR() __builtin_amdgcn_sched_barrier(0)
__device__ __forceinline__ int v_st(int k, int c) { const int kk = (k & ~0xC) | ((k & 4) << 1) | ((k & 8) >> 1); return ((kk >> 3) * 4 + (c >> 5)) * 512 + ((kk & 7) * 32 + (c & 31)) * 2; }
__device__ __forceinline__ int v_rd_base(int lane) { return ((lane & 3) << 3) | (((lane >> 2) & 3) << 6) | (((lane >> 4) & 1) << 5) | (((lane >> 5) & 1) << 8); }
constexpr int v_rd_off(int d0, int ks, int half) { return d0 * 512 + ks * 4096 + half * 2048; }
__device__ __forceinline__ int crow(int r, int hi) { return (r & 3) + 8 * (r >> 2) + 4 * hi; }
__device__ __forceinline__ unsigned cvtpk(float lo, float hi) {
    unsigned r; asm volatile("v_cvt_pk_bf16_f32 %0, %1, %2" : "=v"(r) : "v"(lo), "v"(hi)); return r;
}
__device__ __forceinline__ bf16x8 pack8(f32x4 a, f32x4 b) {
    u32x4 w = {cvtpk(a[0], a[1]), cvtpk(a[2], a[3]), cvtpk(b[0], b[1]), cvtpk(b[2], b[3])};
    return *reinterpret_cast<bf16x8*>(&w);
}
template <class T> __device__ __forceinline__ bf16x8 load8(const T* p) {
    if constexpr (same_t<T, float>::v) { return pack8(*(const f32x4*)p, *(const f32x4*)(p + 4)); }
    else { return *reinterpret_cast<const bf16x8*>(p); }
}
__device__ __forceinline__ void mask_tile(f32x16& p0, f32x16& p1, int dq, unsigned W) {
    const float NEG = -__builtin_inff();
#pragma unroll
    for (int r = 0; r < 16; ++r) {
        const int c = (r & 3) + 8 * (r >> 2);
        if ((unsigned)(dq - c) >= W) p0[r] = NEG;
        if ((unsigned)(dq - c - 32) >= W) p1[r] = NEG;
    }
}
__device__ __forceinline__ void partialSM(f32x16& p0, f32x16& p1, float& m_reg, float& mn, float& alpha) {
    float pmax = p0[0]; for (int r = 1; r < 16; ++r) pmax = fmaxf(pmax, p0[r]); for (int r = 0; r < 16; ++r) pmax = fmaxf(pmax, p1[r]);
    { auto rr = __builtin_amdgcn_permlane32_swap(__float_as_uint(pmax), __float_as_uint(pmax), false, false);
      pmax = fmaxf(__uint_as_float(rr[0]), __uint_as_float(rr[1])); }
    constexpr float C2 = 1.4426950408889634f * SCALE;
    if (__builtin_expect(__all((pmax - m_reg) * SCALE <= THR), 1)) { mn = m_reg; alpha = 1.f; }
    else { mn = fmaxf(m_reg, pmax); alpha = __builtin_amdgcn_exp2f((m_reg - mn) * C2); m_reg = mn; }
    const float mnL = -mn * C2;
    for (int r = 0; r < 16; ++r) p0[r] = fmaf(p0[r], C2, mnL); for (int r = 0; r < 16; ++r) p1[r] = fmaf(p1[r], C2, mnL);
    for (int r = 0; r < 16; ++r) p0[r] = __builtin_amdgcn_exp2f(p0[r]);
}
__device__ __forceinline__ void finishSM(f32x16& p0, f32x16& p1, float alpha, float& l_reg, bf16x8& pa0, bf16x8& pa1, bf16x8& pa2, bf16x8& pa3) {
    for (int r = 0; r < 16; ++r) p1[r] = __builtin_amdgcn_exp2f(p1[r]);
    float ps = 0; for (int r = 0; r < 16; ++r) ps += p0[r]; for (int r = 0; r < 16; ++r) ps += p1[r];
    { auto rr = __builtin_amdgcn_permlane32_swap(__float_as_uint(ps), __float_as_uint(ps), false, false);
      ps = __uint_as_float(rr[0]) + __uint_as_float(rr[1]); }
    l_reg = l_reg * alpha + ps;
#define PK4(P, B_, OUT) do { unsigned a0 = cvtpk(P[B_+0], P[B_+1]), a1 = cvtpk(P[B_+2], P[B_+3]);                          \
        unsigned b0 = cvtpk(P[B_+4], P[B_+5]), b1 = cvtpk(P[B_+6], P[B_+7]);                                             \
        auto r0 = __builtin_amdgcn_permlane32_swap(a0, b0, false, false); auto r1 = __builtin_amdgcn_permlane32_swap(a1, b1, false, false); \
        u32x4 w = {r0[0], r1[0], r0[1], r1[1]}; OUT = *reinterpret_cast<bf16x8*>(&w); } while (0)
    PK4(p0, 0, pa0); PK4(p0, 8, pa1); PK4(p1, 0, pa2); PK4(p1, 8, pa3);
#undef PK4
}
template <int KB, bool SK>
__device__ __forceinline__ void qkt(f32x16& p0, f32x16& p1, const char* K_lds, int r32, int hi, const bf16x8* qr, bool act) {
    if (SK && !act) { const float NEG = -__builtin_inff();
#pragma unroll
        for (int r = 0; r < 16; ++r) { p0[r] = NEG; p1[r] = NEG; } return; }
    { const char* fb = K_lds + 2 * SHM_K + NW * 64 * 4 + KB * 256 + hi * 16;
#pragma unroll
      for (int g = 0; g < 4; ++g) { const f32x4 t0 = *reinterpret_cast<const f32x4*>(fb + g * 32), t1 = *reinterpret_cast<const f32x4*>(fb + 128 + g * 32);
#pragma unroll
          for (int e = 0; e < 4; ++e) { p0[4 * g + e] = t0[e]; p1[4 * g + e] = t1[e]; } } }
    const char* kb[4];
#pragma unroll
    for (int dd = 0; dd < 4; ++dd) kb[dd] = K_lds + KB * SHM_K + KSWZ(r32, (dd * 16 + hi * 8) * 2);
#pragma unroll
    for (int d0 = 0; d0 < 8; ++d0) { const char* a = kb[d0 & 3] + (d0 >> 2) * 128;
        bf16x8 b0 = *reinterpret_cast<const bf16x8*>(a);
        bf16x8 b1 = *reinterpret_cast<const bf16x8*>(a + 32 * 256);
        p0 = __builtin_amdgcn_mfma_f32_32x32x16_bf16(b0, qr[d0], p0, 0, 0, 0);
        p1 = __builtin_amdgcn_mfma_f32_32x32x16_bf16(b1, qr[d0], p1, 0, 0, 0); }
}
template <int VB, bool SK>
__device__ __forceinline__ void pv_tile(f32x16* o, int vb0, bf16x8 pa0, bf16x8 pa1, bf16x8 pa2, bf16x8 pa3, bool act) {
    if (SK && !act) return;
#define TRRD(dst, off) asm volatile("ds_read_b64_tr_b16 %0, %1 offset:%2" : "=&v"(dst) : "v"(vb0), "i"(off) : "memory")
#define PV_D0(d0) do { s16x4 l0, l1, l2, l3, h0, h1, h2, h3; constexpr int b_ = VB * SHM_V + v_rd_off(d0, 0, 0);     \
        TRRD(l0, b_); TRRD(h0, b_ + 2048); TRRD(l1, b_ + 4096); TRRD(h1, b_ + 6144); TRRD(l2, b_ + 8192); TRRD(h2, b_ + 10240); TRRD(l3, b_ + 12288); TRRD(h3, b_ + 14336); \
        asm volatile("s_waitcnt lgkmcnt(0)" ::: "memory"); SBAR();                 \
        o[d0] = __builtin_amdgcn_mfma_f32_32x32x16_bf16(pa0, (bf16x8){l0[0], l0[1], l0[2], l0[3], h0[0], h0[1], h0[2], h0[3]}, o[d0], 0, 0, 0);   \
        o[d0] = __builtin_amdgcn_mfma_f32_32x32x16_bf16(pa1, (bf16x8){l1[0], l1[1], l1[2], l1[3], h1[0], h1[1], h1[2], h1[3]}, o[d0], 0, 0, 0);   \
        o[d0] = __builtin_amdgcn_mfma_f32_32x32x16_bf16(pa2, (bf16x8){l2[0], l2[1], l2[2], l2[3], h2[0], h2[1], h2[2], h2[3]}, o[d0], 0, 0, 0);   \
        o[d0] = __builtin_amdgcn_mfma_f32_32x32x16_bf16(pa3, (bf16x8){l3[0], l3[1], l3[2], l3[3], h3[0], h3[1], h3[2], h3[3]}, o[d0], 0, 0, 0); } while (0)
    PV_D0(0); PV_D0(1); PV_D0(2); PV_D0(3);
#undef PV_D0
#undef TRRD
}

template <class TIn, class TOut> struct BlockRef { const TIn* Q; const TIn* K; const TIn* V; TOut* O; const float* FB; int P0; int JLO; };
template <class TIn> struct Seam {
    bf16x8 qr[8];
    bf16x8 st_v0, st_v1, st_k0, st_k1; f32x4 sf0, sf1, sf2, sf3; float st_f;
    f32x4 tq[16];
};
__device__ __forceinline__ int swa_jlo(int P0, int W) { const int lowk = P0 - W + 1; return lowk > 0 ? lowk / KVBLK : 0; }
#define ROW(p, k0, rr) ((p) + (size_t)((k0) + (rr)) * D + sc)
#define VMW() asm volatile("s_waitcnt vmcnt(0)" ::: "memory")
#define VMWN(n) asm volatile("s_waitcnt vmcnt(%0)" :: "i"(n) : "memory")
#define SLOAD_H(Kp, Vp, Fp, k0) do { S.st_v0 = load8<TIn>(ROW(Vp, k0, sr)); S.st_v1 = load8<TIn>(ROW(Vp, k0, 32 + sr));              \
                         S.st_k0 = load8<TIn>(ROW(Kp, k0, sr)); S.st_k1 = load8<TIn>(ROW(Kp, k0, 32 + sr)); S.st_f = (Fp)[(k0) + (tid & 63)]; } while (0)
#define SWRITE_HK(bf) do { *(bf16x8*)(K_lds + (bf) * SHM_K + kws) = S.st_k0; *(bf16x8*)(K_lds + (bf) * SHM_K + kws + 32 * 256) = S.st_k1; if (tid < 64) *(float*)(K_lds + 2 * SHM_K + NW * 64 * 4 + (bf) * 256 + tid * 4) = S.st_f; } while (0)
#define SWRITE_HV(bf) do { *(bf16x8*)(V_lds + (bf) * SHM_V + vst0) = S.st_v0; *(bf16x8*)(V_lds + (bf) * SHM_V + vst1) = S.st_v1; } while (0)
#define SWRITE_H(bf) do { SWRITE_HV(bf); SWRITE_HK(bf); } while (0)
#define SLOAD_F(p, k0) do { S.sf0 = *(const f32x4*)ROW(p, k0, sr); S.sf1 = *(const f32x4*)(ROW(p, k0, sr) + 4);                \
                            S.sf2 = *(const f32x4*)ROW(p, k0, 32 + sr); S.sf3 = *(const f32x4*)(ROW(p, k0, 32 + sr) + 4); } while (0)
#define SWRITE_KF(bf) do { *(bf16x8*)(K_lds + (bf) * SHM_K + kws) = pack8(S.sf0, S.sf1); *(bf16x8*)(K_lds + (bf) * SHM_K + kws + 32 * 256) = pack8(S.sf2, S.sf3); } while (0)
#define SWRITE_VF(bf) do { *(bf16x8*)(V_lds + (bf) * SHM_V + vst0) = pack8(S.sf0, S.sf1); *(bf16x8*)(V_lds + (bf) * SHM_V + vst1) = pack8(S.sf2, S.sf3); } while (0)
template <class TIn, class TOut>
__device__ __forceinline__ void causal_swa_prime(const BlockRef<TIn, TOut>& cur, int W, char* lds, Seam<TIn>& S) {
    constexpr bool F32 = same_t<TIn, float>::v;
    const int tid = threadIdx.x, wid = __builtin_amdgcn_readfirstlane(tid >> 6), lane = tid & 63, r32 = lane & 31, hi = lane >> 5;
    const int sr = tid >> 4, sc = (tid & 15) * 8, kws = KSWZ(sr, sc * 2); char* K_lds = lds + 2 * SHM_V;
    const int kb0 = cur.JLO * KVBLK;
    for (int d0 = 0; d0 < 8; ++d0) S.qr[d0] = load8<TIn>(cur.Q + (size_t)(wid * QBLK + r32) * D + d0 * 16 + hi * 8);
    if constexpr (F32) { SLOAD_F((const float*)cur.K, kb0); VMW(); SWRITE_KF(0); SBAR(); SLOAD_F((const float*)cur.V, kb0); }
    else { SLOAD_H(cur.K, cur.V, cur.FB, kb0); VMW(); SWRITE_HK(0); }
    __syncthreads();
}
template <class TIn, class TOut>
__device__ __forceinline__ void causal_swa_block(const BlockRef<TIn, TOut>& cur, const BlockRef<TIn, TOut>& nxt, int skv, int W, char* lds, Seam<TIn>& S) {
    constexpr bool F32 = same_t<TIn, float>::v;
    const int tid = threadIdx.x, wid = __builtin_amdgcn_readfirstlane(tid >> 6), lane = tid & 63, r32 = lane & 31, hi = lane >> 5;
    const int j_lo = cur.JLO;
    int j_hi = (cur.P0 + QB - 1) / KVBLK + 1; if (j_hi > skv / KVBLK) j_hi = skv / KVBLK;
    const int NT = j_hi - j_lo;
    const int kbn = nxt.JLO * KVBLK;
    const int qlo = cur.P0 + wid * QBLK, qm = qlo + r32 - 4 * hi;
    char* V_lds = lds; char* K_lds = lds + 2 * SHM_V;
    float* ws = (float*)(lds + 2 * SHM_V + 2 * SHM_K) + wid * 64; float* li_l = ws, * al_l = ws + 32;
    float m_reg = -1e30f, l_reg = 0; f32x16 o[4] = {};
    const int sr = tid >> 4, sc = (tid & 15) * 8, vst0 = v_st(sr, sc), vst1 = v_st(32 + sr, sc), kws = KSWZ(sr, sc * 2);
    const int vb0 = (int)(uintptr_t)V_lds + v_rd_base(lane);
    const TIn* Kh = cur.K; const TIn* Vh = cur.V; const float* Fh = cur.FB;
#define RESC(a) do { if (__any((a) < 1.f)) { if (hi == 0) al_l[r32] = (a); asm volatile("s_waitcnt lgkmcnt(0)" ::: "memory");              \
                     for (int d_ = 0; d_ < 4; ++d_) for (int r = 0; r < 16; ++r) o[d_][r] *= al_l[crow(r, hi)]; } } while (0)
#define KBASE(t) ((j_lo + (t)) * KVBLK)
#define ACT(t) (KBASE(t) <= qlo + QBLK - 1 && KBASE(t) + KVBLK - 1 >= qlo - W + 1)
#define MASKT(P0_, P1_, t) do { const int kb_ = KBASE(t); if ((!SK || ACT(t)) && (kb_ + KVBLK - 1 > qlo || kb_ <= qlo + QBLK - 1 - W)) mask_tile(P0_, P1_, qm - kb_, (unsigned)W); } while (0)
    constexpr int NQL = F32 ? 16 : 8;
    constexpr bool SK = WSKIP && !F32;
#define SEAM_K0() do { VMWN(NQL); if constexpr (F32) { SWRITE_KF(0); SBAR(); SLOAD_F((const float*)nxt.V, kbn); } else { SWRITE_HK(0); } SBAR(); } while (0)
    f32x16 pA0, pA1, pB0, pB1; float mnA, mnB, alA, alB; bf16x8 pa0, pa1, pa2, pa3;
    if constexpr (F32) { VMW(); SWRITE_VF(0); SBAR(); } else { SWRITE_HV(0); SBAR(); }
    if (NT > 1) { if constexpr (F32) SLOAD_F((const float*)Kh, KBASE(1)); else SLOAD_H(Kh, Vh, Fh, KBASE(1)); }
    SBAR(); qkt<0, SK>(pA0, pA1, K_lds, r32, hi, S.qr, ACT(0));
    if constexpr (F32) { if (NT > 1) { VMW(); SWRITE_KF(1); SBAR(); SLOAD_F((const float*)Vh, KBASE(1)); } }
    MASKT(pA0, pA1, 0); partialSM(pA0, pA1, m_reg, mnA, alA);
    if (NT > 1) { VMW(); if constexpr (F32) { SWRITE_VF(1); SBAR(); if (NT > 2) SLOAD_F((const float*)Kh, KBASE(2)); } else SWRITE_H(1); }
    __syncthreads();
#define HALF_STEP(PX0, PX1, mnX, alX, PY0, PY1, alY, t, KB, VB, SB) do {                                                      \
        SBAR(); qkt<KB, SK>(PX0, PX1, K_lds, r32, hi, S.qr, ACT(t));                                             \
        finishSM(PY0, PY1, alY, l_reg, pa0, pa1, pa2, pa3); SBAR();                                                           \
        if ((t) + 1 < NT) { if constexpr (F32) { VMW(); SWRITE_KF(SB); SBAR(); SLOAD_F((const float*)Vh, KBASE((t) + 1)); }  \
                            else { SLOAD_H(Kh, Vh, Fh, KBASE((t) + 1)); } SBAR(); }                                               \
        pv_tile<VB, SK>(o, vb0, pa0, pa1, pa2, pa3, ACT((t) - 1)); MASKT(PX0, PX1, (t)); partialSM(PX0, PX1, m_reg, mnX, alX);                                        \
        __syncthreads();                                                                                                      \
        if ((t) + 1 < NT) { VMW(); if constexpr (F32) { SWRITE_VF(SB); SBAR(); if ((t) + 2 < NT) SLOAD_F((const float*)Kh, KBASE((t) + 2)); } \
                            else { SWRITE_H(SB); } }                                                                          \
        RESC(alX); __syncthreads(); } while (0)
    for (int t = 1; t + 1 < NT; t += 2) {
        HALF_STEP(pB0, pB1, mnB, alB, pA0, pA1, alA, t, 1, 0, 0);
        HALF_STEP(pA0, pA1, mnA, alA, pB0, pB1, alB, t + 1, 0, 1, 1);
    }
    const bool even = (NT & 1) == 0;
    if (even) { SBAR(); qkt<1, SK>(pB0, pB1, K_lds, r32, hi, S.qr, ACT(NT - 1)); SBAR(); }
#define QROW(e) (nxt.Q + (size_t)(wid * QBLK + r32) * D + ((e) >> 1) * 16 + hi * 8 + ((e) & 1) * 4)
    if constexpr (F32) { SLOAD_F((const float*)nxt.K, kbn); SBAR();
#pragma unroll
        for (int e = 0; e < 8; ++e) S.tq[e] = *(const f32x4*)QROW(e); }
    else { SLOAD_H(nxt.K, nxt.V, nxt.FB, kbn); SBAR();
#pragma unroll
        for (int d0 = 0; d0 < 8; ++d0) S.qr[d0] = load8<TIn>(nxt.Q + (size_t)(wid * QBLK + r32) * D + d0 * 16 + hi * 8); }
    SBAR();
    finishSM(pA0, pA1, alA, l_reg, pa0, pa1, pa2, pa3); SBAR();
    if constexpr (F32) {
#pragma unroll
        for (int e = 8; e < 16; ++e) S.tq[e] = *(const f32x4*)QROW(e); SBAR(); }
#undef QROW
    pv_tile<0, SK>(o, vb0, pa0, pa1, pa2, pa3, ACT(even ? NT - 2 : NT - 1));
    if (even) { MASKT(pB0, pB1, NT - 1); partialSM(pB0, pB1, m_reg, mnB, alB); __syncthreads(); RESC(alB);
        finishSM(pB0, pB1, alB, l_reg, pa0, pa1, pa2, pa3); SBAR(); pv_tile<1, SK>(o, vb0, pa0, pa1, pa2, pa3, ACT(NT - 1)); }
    SBAR(); SEAM_K0();
    if (hi == 0) li_l[r32] = l_reg; asm volatile("s_waitcnt lgkmcnt(0)" ::: "memory");
    float rli[16];
#pragma unroll
    for (int r = 0; r < 16; ++r) rli[r] = __builtin_amdgcn_rcpf(li_l[crow(r, hi)]);
    TOut* Ow = cur.O + (size_t)(wid * QBLK) * OPITCH;
#pragma unroll
    for (int r = 0; r < 16; ++r) { const int orow = crow(r, hi);
#pragma unroll
        for (int d0 = 0; d0 < 4; ++d0) { const float v = o[d0][r] * rli[r];
            if constexpr (same_t<TOut, float>::v) { Ow[(size_t)orow * OPITCH + d0 * 32 + r32] = v; }
            else { const float vn = __shfl_xor(v, 1);
                   if ((r32 & 1) == 0) *(unsigned*)(Ow + (size_t)orow * OPITCH + d0 * 32 + r32) = cvtpk(v, vn); } } }
    if constexpr (F32) {
#pragma unroll
        for (int d0 = 0; d0 < 8; ++d0) S.qr[d0] = pack8(S.tq[2 * d0], S.tq[2 * d0 + 1]); }
    __syncthreads();
#undef RESC
#undef KBASE
#undef ACT
#undef MASKT
#undef SEAM_K0
#undef HALF_STEP
}
#undef ROW
#undef VMW
#undef VMWN
#undef SLOAD_H
#undef SWRITE_HK
#undef SWRITE_HV
#undef SWRITE_H
#undef SLOAD_F
#undef SWRITE_KF
#undef SWRITE_VF

}

struct Args { const float* in[21]; float* out; unsigned char* ws; int ph_lo, ph_hi; };
template <int OFF> __device__ __forceinline__ unsigned long long karg64() { unsigned long long v; asm volatile("s_load_dwordx2 %0, %1, %2\n\ts_waitcnt lgkmcnt(0)" : "=s"(v) : "s"(__builtin_amdgcn_kernarg_segment_ptr()), "n"(OFF) : "memory"); return v; }
#define ARG_IN(i) ((const float*)(const GAS float*)karg64<(i) * 8>())
#define ARG_OUT ((float*)(GAS float*)karg64<168>())
#define ARG_WS ((unsigned char*)(GAS unsigned char*)karg64<176>())
struct Frame {
    LAS unsigned char* lds; volatile LAS unsigned* MISC; unsigned* ctl;
    int tid, lane, wave, vcu, G, gw, NGW;
};

struct EpiProj {
    static constexpr bool PERM = true, AFTER_DRAIN = false;
    bf16* QKVA; bf16* Z; bf16* QKVB;
    __device__ __forceinline__ void operator()(const pg8::f32x4 (&acc)[2][2][4][2], const pg8::Unit& u, int wr, int wc, int fr, int fq) const {
        const int row0 = u.pm * 256 + wr * 64 + fr, pn = u.pn, cin = wc * 32 + 8 * fq;
#pragma unroll
        for (int ai = 0; ai < 2; ++ai)
#pragma unroll
            for (int m = 0; m < 4; ++m) { const int row = row0 + ai * 128 + m * 16;
#pragma unroll
                for (int bj = 0; bj < 2; ++bj) { const pg8::f32x4 v0 = acc[ai][bj][m][0], v1 = acc[ai][bj][m][1];
                    v4u w; w.x = pk2(v0[0], v0[1]); w.y = pk2(v0[2], v0[3]); w.z = pk2(v1[0], v1[1]); w.w = pk2(v1[2], v1[3]);
                    bf16* dst;
                    if (pn < 12) dst = QKVA + (size_t)row * 3072 + pn * 256 + bj * 128 + cin;
                    else if (pn < 16) dst = Z + (size_t)row * 1024 + (pn - 12) * 256 + bj * 128 + cin;
                    else { const int q = pn - 16, tensor = q >> 2, head = (q & 3) * 2 + bj, b = row >> 12, t = row & 4095;
                        dst = QKVB + (size_t)tensor * QKVB_STRIDE + ((size_t)((b * NH + head) * SEQ + t)) * HD + cin; }
                    *(v4u*)dst = w; } }
    }
};
struct EpiMix {
    static constexpr bool PERM = true, AFTER_DRAIN = false;
    const float* x; const float* mod; bf16* out;
    __device__ __forceinline__ void operator()(const pg8::f32x4 (&acc)[2][2][4][2], const pg8::Unit& u, int wr, int wc, int fr, int fq) const {
        const int row0 = u.pm * 256 + wr * 64 + fr, col0 = u.pn * 256 + wc * 32 + 8 * fq, b = u.pm >> 4;
        f32x4 gv[2][2];
#pragma unroll
        for (int bj = 0; bj < 2; ++bj)
#pragma unroll
            for (int n = 0; n < 2; ++n) gv[bj][n] = *(const f32x4*)(mod + b * 12288 + 2 * D + col0 + bj * 128 + n * 4);
#pragma unroll
        for (int ai = 0; ai < 2; ++ai)
#pragma unroll
            for (int m = 0; m < 4; ++m) { const size_t off = (size_t)(row0 + ai * 128 + m * 16) * D + col0;
#pragma unroll
                for (int bj = 0; bj < 2; ++bj) { const f32x4 x0 = *(const f32x4*)(x + off + bj * 128), x1 = *(const f32x4*)(x + off + bj * 128 + 4);
                    const f32x4 r0 = x0 + gv[bj][0] * acc[ai][bj][m][0], r1 = x1 + gv[bj][1] * acc[ai][bj][m][1];
                    v4u w; w.x = pk2(r0[0], r0[1]); w.y = pk2(r0[2], r0[3]); w.z = pk2(r1[0], r1[1]); w.w = pk2(r1[2], r1[3]);
                    *(v4u*)(out + off + bj * 128) = w; } }
    }
};

__device__ __forceinline__ void transpose_item(const float* W, int ldw, int csrc, bf16* WT, int ldt, int drow0, int k0, LAS float* scr, int lane, int mode) {
#pragma unroll 8
    for (int i = 0; i < 32; ++i) { const int kk = 2 * i + (lane >> 5); scr[kk * 33 + (lane & 31)] = W[(size_t)(k0 + kk) * ldw + csrc + (lane & 31)]; }
    LDS_WAIT(); asm volatile("" ::: "memory");
    const int c = lane & 7;
#pragma unroll
    for (int j = 0; j < 4; ++j) { const int n = (lane >> 3) + 8 * j; const LAS float* s = scr + (8 * c) * 33 + n;
        v4u o; o.x = pk2(s[0 * 33], s[1 * 33]); o.y = pk2(s[2 * 33], s[3 * 33]); o.z = pk2(s[4 * 33], s[5 * 33]); o.w = pk2(s[6 * 33], s[7 * 33]);
        int dr;
        if (mode == 0) dr = drow0 + n;
        else dr = drow0 + ((n >> 4) << 5) + (n & 15) + (mode == 2 ? 16 : 0);
        *(GAS v4u*)(WT + (size_t)dr * ldt + k0 + 8 * c) = o; }
    LDS_WAIT(); asm volatile("" ::: "memory");
}
__device__ __forceinline__ void p0_prologue(Frame& F, const Args& A) {
    LAS float* scr = (LAS float*)(F.lds + F.wave * 16384);
    unsigned char* ws = ARG_WS;
    const float* w_in = ARG_IN(5); const float* w_out = ARG_IN(11);
    bf16* WINT = (bf16*)(ws + WS_WINT); bf16* WOUTT = (bf16*)(ws + WS_WOUTT);
    constexpr int I_G = 32 * 32, I_IN = 7 * I_G, I_OUT = 32 * 64, I_E13 = 32 * 16, I_13 = NE * I_E13, I_E2 = 8 * 64, I_2 = NE * I_E2;
    bf16* W13T = (bf16*)(ws + WS_W13T); bf16* W2T = (bf16*)(ws + WS_W2T);
    for (int it = F.gw; it < I_IN + I_OUT + 2 * I_13 + I_2; it += F.NGW) {
        if (it < I_IN) { const int g = it / I_G, r = it % I_G, kb = r / 32, nb = r % 32;
            const int src0 = (g < 4) ? g * 1024 : 4112 + (g - 4) * 1024;
            transpose_item(w_in, INW, src0 + nb * 32, WINT, D, g * 1024 + nb * 32, kb * 64, scr, F.lane, 0); }
        else if (it < I_IN + I_OUT) { const int r = it - I_IN, kb = r / 64, nb = r % 64;
            transpose_item(w_out, D, nb * 32, WOUTT, D, nb * 32, kb * 64, scr, F.lane, 0); }
        else if (it < I_IN + I_OUT + 2 * I_13) { int r = it - I_IN - I_OUT; const int which = r / I_13; r %= I_13; const int e = r / I_E13, q = r % I_E13, kb = q / 16, nb = q % 16;
            transpose_item((which ? ARG_IN(18) : ARG_IN(17)) + (size_t)e * D * DE, DE, nb * 32, W13T + (size_t)e * 1024 * D, D, nb * 64, kb * 64, scr, F.lane, which ? 2 : 1); }
        else { const int r = it - I_IN - I_OUT - 2 * I_13, e = r / I_E2, q = r % I_E2, kb = q / 64, nb = q % 64;
            transpose_item(ARG_IN(19) + (size_t)e * DE * D, D, nb * 32, W2T + (size_t)e * D * DE, DE, nb * 32, kb * 64, scr, F.lane, 0); }
    }
    { bf16* WST = (bf16*)(ws + WS_WST); bf16* WRT = (bf16*)(ws + WS_WRT); const float* w_rg = ARG_IN(13); const float* w_re = ARG_IN(15);
      const int gt = F.vcu * NTHR + F.tid, NT_ = F.G * NTHR;
      for (int i = gt; i < 80 * 2048; i += NT_) { const int n = i >> 11, k = i & 2047;
          if (n < 32) { float v = 0.f; if (n < 8) v = w_in[(size_t)k * INW + 4096 + n]; else if (n < 16) v = w_in[(size_t)k * INW + 4104 + (n - 8)]; else if (n < 24) v = w_in[(size_t)k * INW + 7184 + (n - 16)];
              WST[n * 2048 + k] = (bf16)f2bf(v); }
          else { const int r = n - 32; float v = 0.f; if (r < 4) v = w_rg[k * 4 + r]; else if (r < 36) v = w_re[k * 32 + (r - 4)];
              WRT[r * 2048 + k] = (bf16)f2bf(v); } } }
    { const float* cvec = ARG_IN(1); const float* w_ada = ARG_IN(2); const float* b_ada = ARG_IN(3); float* mod = (float*)(F.ctl + CW_MOD);
      __syncthreads();
      LAS float* sc = (LAS float*)F.lds;
      LAS float* red = sc + 8192;
      for (int i = F.tid; i < 4 * D; i += NTHR) sc[i] = siluf(cvec[i]);
      LDS_WAIT(); __syncthreads();
      const int cl = F.tid & 15, kg = F.tid >> 4;
      for (int cb = F.vcu; cb < 192; cb += F.G) { const int n0 = cb * 64 + 4 * cl;
          f32x4 acc[4];
#pragma unroll
          for (int b = 0; b < 4; ++b) acc[b] = (f32x4){0.f, 0.f, 0.f, 0.f};
#pragma unroll 4
          for (int it = 0; it < 64; ++it) { const int k = kg + 32 * it; const f32x4 w = *(const GAS f32x4*)(w_ada + (size_t)k * 12288 + n0);
#pragma unroll
              for (int b = 0; b < 4; ++b) acc[b] += sc[b * D + k] * w; }
#pragma unroll
          for (int b = 0; b < 4; ++b)
#pragma unroll
              for (int j = 0; j < 4; ++j) { float v = acc[b][j]; v += __shfl_xor(v, 16); v += __shfl_xor(v, 32); acc[b][j] = v; }
          if (F.lane < 16) {
#pragma unroll
              for (int b = 0; b < 4; ++b) *(LAS f32x4*)(red + (F.wave * 4 + b) * 64 + 4 * cl) = acc[b]; }
          LDS_WAIT(); __syncthreads();
          if (F.tid < 256) { const int b = F.tid >> 6, c = F.tid & 63; float s = b_ada[cb * 64 + c];
#pragma unroll
              for (int w = 0; w < 8; ++w) s += red[(w * 4 + b) * 64 + c];
              mod[b * 12288 + cb * 64 + c] = s; }
          __syncthreads(); } }
}

__device__ __forceinline__ void route_token(const Args& A, unsigned* ctl, int token);
template <int NT, bool ROUTE, bool XBF>
__device__ __forceinline__ void norm_rows_skinny(Frame& F, const Args& A, const void* xin_, const float* gvec, const float* modsh, const float* modsc, bf16* Hout, const bf16* WT, float* outS, int ldS) {
    LAS f32x4* comb = (LAS f32x4*)F.lds;
    for (int blk = F.vcu; blk < M / 64; blk += F.G) {
        const int R0 = blk * 64, b = R0 >> 12, rw = R0 + 8 * F.wave;
        f32x4 gm[8], sh[8];
#pragma unroll
        for (int j = 0; j < 8; ++j) { const int k = 4 * F.lane + 256 * j; gm[j] = *(const f32x4*)(gvec + k) * (*(const f32x4*)(modsc + b * 12288 + k) + 1.0f); sh[j] = *(const f32x4*)(modsh + b * 12288 + k); }
        f32x4 va[8], vb[8];
#define NR_LOAD(dst, row) do { if constexpr (XBF) { const GAS v2u* xr_ = (const GAS v2u*)((const bf16*)xin_ + (size_t)(row) * D) + F.lane; _Pragma("unroll") for (int j = 0; j < 8; ++j) { const v2u t_ = xr_[64 * j]; dst[j] = (f32x4){bflo(t_.x), bfhi(t_.x), bflo(t_.y), bfhi(t_.y)}; } } \
            else { const GAS f32x4* xr_ = (const GAS f32x4*)((const float*)xin_ + (size_t)(row) * D) + F.lane; _Pragma("unroll") for (int j = 0; j < 8; ++j) dst[j] = xr_[64 * j]; } } while (0)
#define NR_PROC(v, row) do { float s_ = 0.f; _Pragma("unroll") for (int j = 0; j < 8; ++j) s_ += (v[j].x * v[j].x + v[j].y * v[j].y) + (v[j].z * v[j].z + v[j].w * v[j].w); \
            const float r_ = __builtin_amdgcn_rsqf(wave_sum(s_) * (1.f / D) + EPS); GAS v2u* o8_ = (GAS v2u*)(Hout + (size_t)(row) * D) + F.lane; \
            _Pragma("unroll") for (int j = 0; j < 8; ++j) { const f32x4 h_ = (v[j] * r_) * gm[j] + sh[j]; v2u w_; w_.x = pk2(h_.x, h_.y); w_.y = pk2(h_.z, h_.w); o8_[64 * j] = w_; } } while (0)
        NR_LOAD(va, rw);
#pragma unroll
        for (int rr = 0; rr < 8; rr += 2) { NR_LOAD(vb, rw + rr + 1); NR_PROC(va, rw + rr); if (rr + 2 < 8) NR_LOAD(va, rw + rr + 2); NR_PROC(vb, rw + rr + 1); }
#undef NR_LOAD
#undef NR_PROC
        VM_WAIT(); __syncthreads();
        const int rt = F.wave & 3, kh = F.wave >> 2, l15 = F.lane & 15, l4 = F.lane >> 4;
        pg8::f32x4 acc[NT];
#pragma unroll
        for (int t = 0; t < NT; ++t) acc[t] = (pg8::f32x4){0.f, 0.f, 0.f, 0.f};
        const bf16* arow = Hout + (size_t)(R0 + 16 * rt + l15) * D + 8 * l4 + 1024 * kh;
        const bf16* brow = WT + (size_t)l15 * D + 8 * l4 + 1024 * kh;
#pragma unroll 4
        for (int s = 0; s < 32; ++s) { const bf16x8 a = *(const GAS bf16x8*)(arow + 32 * s);
#pragma unroll
            for (int t = 0; t < NT; ++t) { const bf16x8 bb = *(const GAS bf16x8*)(brow + (size_t)t * 16 * D + 32 * s);
                acc[t] = __builtin_amdgcn_mfma_f32_16x16x32_bf16(a, bb, acc[t], 0, 0, 0); } }
        if (kh == 1) {
#pragma unroll
            for (int t = 0; t < NT; ++t) comb[(rt * NT + t) * 64 + F.lane] = acc[t]; }
        LDS_WAIT(); __syncthreads();
        if (kh == 0) {
#pragma unroll
            for (int t = 0; t < NT; ++t) { const f32x4 o = acc[t] + comb[(rt * NT + t) * 64 + F.lane];
#pragma unroll
                for (int rg = 0; rg < 4; ++rg) outS[(size_t)(R0 + 16 * rt + 4 * l4 + rg) * ldS + 16 * t + l15] = o[rg]; }
            if constexpr (ROUTE) { VM_WAIT(); if (F.lane < 16) route_token(A, F.ctl, R0 + 16 * rt + F.lane); } }
        __syncthreads();
    }
}

__device__ __forceinline__ void p3_cumf(Frame& F, const Args& A) {
    const float* small = (const float*)(ARG_WS + WS_SMALL); float* cumf = (float*)(ARG_WS + WS_CUMF); const float* fbias = ARG_IN(10);
    LAS float* red = (LAS float*)F.lds;
    for (int bh = F.vcu - (F.G >= 160 ? 128 : 0); bh < BATCH * NH; bh += F.G) { if (bh < 0) continue; const int b = bh >> 3, h = bh & 7; const float fb = fbias[h];
        float v[8]; float run = 0.f;
#pragma unroll
        for (int i = 0; i < 8; ++i) { const int t = F.tid * 8 + i; run += logsigmoidf_(small[(size_t)(b * SEQ + t) * 32 + 16 + h] + fb); v[i] = run; }
        float inc = run;
#pragma unroll
        for (int o = 1; o < 64; o <<= 1) { const float t_ = __shfl_up(inc, o); if (F.lane >= o) inc += t_; }
        if (F.lane == 63) red[F.wave] = inc;
        LDS_WAIT(); __syncthreads();
        float base = inc - run;
        for (int w = 0; w < F.wave; ++w) base += red[w];
#pragma unroll
        for (int i = 0; i < 8; ++i) cumf[(size_t)bh * SEQ + F.tid * 8 + i] = -(base + v[i]) * 11.313708498984761f;
        __syncthreads();
    }
}

__device__ __forceinline__ fa::BlockRef<fa::TIN, fa::TOUT> fa_ref(const Args& A, int bh, int qb, const LAS int* jtab) {
    const fa::TIN* QB = (const fa::TIN*)(ARG_WS + WS_QKVB); const fa::TIN* KB = QB + QKVB_STRIDE; const fa::TIN* VB = KB + QKVB_STRIDE;
    fa::BlockRef<fa::TIN, fa::TOUT> r; const int b = bh >> 3, h = bh & 7;
    r.Q = QB + ((size_t)bh * SEQ + (size_t)qb * fa::QB) * HD; r.K = KB + (size_t)bh * SEQ * HD; r.V = VB + (size_t)bh * SEQ * HD;
    r.FB = (const float*)(ARG_WS + WS_CUMF) + (size_t)bh * SEQ;
    r.O = (fa::TOUT*)(ARG_WS + WS_H) + ((size_t)b * SEQ + (size_t)qb * fa::QB) * D + 1024 + h * HD; r.P0 = qb * fa::QB; r.JLO = jtab[bh * 16 + qb];
    return r;
}
__device__ __forceinline__ void p4_normmax(Frame& F, const Args& A) {
    const bf16* QB = (const bf16*)(ARG_WS + WS_QKVB); LAS float* red = (LAS float*)F.lds;
    const int nb = F.G, b0 = 0;
    for (int item = F.vcu - b0; item < BATCH * NH * 2 * 4; item += nb) { if (item < 0) break;
        const int idx = item >> 2, qr = item & 3, bh = idx >> 1, which = idx & 1; const bf16* base = QB + (size_t)which * QKVB_STRIDE + ((size_t)bh * SEQ + qr * 1024) * HD;
        float m = 0.f;
#pragma unroll 8
        for (int it = 0; it < 32; ++it) { const int row = 32 * it + 4 * F.wave + (F.lane >> 4);
            const v4u x = *(const v4u*)(base + (size_t)row * HD + 8 * (F.lane & 15));
            float ss = bflo(x.x) * bflo(x.x) + bfhi(x.x) * bfhi(x.x) + bflo(x.y) * bflo(x.y) + bfhi(x.y) * bfhi(x.y) + bflo(x.z) * bflo(x.z) + bfhi(x.z) * bfhi(x.z) + bflo(x.w) * bflo(x.w) + bfhi(x.w) * bfhi(x.w);
            ss = dpp_add<0xB1>(ss); ss = dpp_add<0x4E>(ss); ss = dpp_add<0x141>(ss); ss = dpp_add<0x140>(ss);
            m = fmaxf(m, ss); }
        m = fmaxf(m, __shfl_xor(m, 16)); m = fmaxf(m, __shfl_xor(m, 32));
        if (F.lane == 0) red[F.wave] = m;
        LDS_WAIT(); __syncthreads();
        if (F.tid == 0) { float t = red[0];
#pragma unroll
            for (int w = 1; w < 8; ++w) t = fmaxf(t, red[w]);
            atomicMax(F.ctl + CW_NMAX + idx, __builtin_bit_cast(unsigned, t)); }
        __syncthreads();
    }
}
constexpr float ATT_LIM_RAW = 30.0f * 11.313708498984761f;
__device__ __forceinline__ void p4_attn(Frame& F, const Args& A, char* lds) {
    constexpr int NQB = SEQ / fa::QB, TOTAL = BATCH * NH * NQB;
    LAS int* jtab = (LAS int*)(F.lds + LDSCTL_OFF + 2048);
    const float* FBall = (const float*)(ARG_WS + WS_CUMF); const unsigned* nmax = F.ctl + CW_NMAX;
    { const int bh = F.tid >> 4, qb = F.tid & 15, P0 = qb * fa::QB; const float* fb = FBall + (size_t)bh * SEQ;
      const float thr = fb[P0] - ATT_LIM_RAW - 2.f * sqrtf(__builtin_bit_cast(float, nmax[bh * 2]) * __builtin_bit_cast(float, nmax[bh * 2 + 1]));
      int lo = 0, hi = P0 / 64;
      for (int it = 0; it < 6; ++it) { const int mid = (lo + hi) >> 1; const bool act = lo < hi; const float v = fb[64 * (act ? mid : 0) + 63]; if (act) { if (v < thr) lo = mid + 1; else hi = mid; } }
      jtab[F.tid] = lo; }
    LAS int* wtab = jtab + 512; LAS int* sorted = jtab + 1024;
    const int myw = 4 * ((F.tid & 15) + 1) - jtab[F.tid] ;
    wtab[F.tid] = myw;
    LDS_WAIT(); __syncthreads();
    { int rank = 0;
#pragma unroll 8
      for (int j = 0; j < TOTAL; ++j) { const int wj = wtab[j]; rank += (wj > myw || (wj == myw && j < F.tid)) ? 1 : 0; }
      sorted[rank] = F.tid; }
    LDS_WAIT(); __syncthreads();
#define FA_POS(r_) ((r_) * F.G + (((r_) & 1) ? F.G - 1 - F.vcu : F.vcu))
#define FA_ITEM(I_) fa_ref(A, (I_) >> 4, (I_) & 15, jtab)
    int r = 0; if (FA_POS(0) >= TOTAL) return;
    fa::BlockRef<fa::TIN, fa::TOUT> cur = FA_ITEM(sorted[FA_POS(0)]);
    fa::Seam<fa::TIN> S;
    fa::causal_swa_prime<fa::TIN, fa::TOUT>(cur, fa::WINDOW, lds, S);
    for (;;) {
        const bool last = FA_POS(r + 1) >= TOTAL;
        const fa::BlockRef<fa::TIN, fa::TOUT> nxt = last ? cur : FA_ITEM(sorted[last ? 0 : FA_POS(r + 1)]);
        fa::causal_swa_block<fa::TIN, fa::TOUT>(cur, nxt, SEQ, fa::WINDOW, lds, S);
        if (last) break;
        cur = nxt; ++r;
    }
#undef FA_ITEM
#undef FA_POS
}

__device__ __forceinline__ void route_token(const Args& A, unsigned* ctl, int token) {
    const float* rl = (const float*)(ARG_WS + WS_RL) + (size_t)token * 48; const float* b_rg = ARG_IN(14); const float* b_re = ARG_IN(16);
    float gl[4]; int gi = 0;
#pragma unroll
    for (int g = 0; g < 4; ++g) { gl[g] = rl[g] + b_rg[g]; }
#pragma unroll
    for (int g = 1; g < 4; ++g) if (gl[g] > gl[gi]) gi = g;
    float gs = 0.f;
#pragma unroll
    for (int g = 0; g < 4; ++g) gs += __expf(gl[g] - gl[gi]);
    const float pg = 1.f / gs;
    float el[8];
#pragma unroll
    for (int e = 0; e < 8; ++e) el[e] = rl[4 + gi * 8 + e] + b_re[gi * 8 + e];
    int i0 = 0;
#pragma unroll
    for (int e = 1; e < 8; ++e) if (el[e] > el[i0]) i0 = e;
    int i1 = (i0 == 0) ? 1 : 0;
#pragma unroll
    for (int e = 0; e < 8; ++e) if (e != i0 && el[e] > el[i1]) i1 = e;
    const float e1 = __expf(el[i1] - el[i0]); const float w0 = pg / (1.f + e1), w1 = pg * e1 / (1.f + e1);
    int* toke = (int*)(ARG_WS + WS_ROUTE + RT_TOKE); float* tokw = (float*)(ARG_WS + WS_ROUTE + RT_TOKW); int* tokr = (int*)(ARG_WS + WS_ROUTE + RT_TOKR);
    const int ge0 = gi * 8 + i0, ge1 = gi * 8 + i1;
    toke[token * 2] = ge0; toke[token * 2 + 1] = ge1; tokw[token * 2] = w0; tokw[token * 2 + 1] = w1;
    tokr[token * 2] = (int)atomicAdd(ctl + CW_CNT + 64 * ge0, 1u); tokr[token * 2 + 1] = (int)atomicAdd(ctl + CW_CNT + 64 * ge1, 1u);
}
__device__ __forceinline__ void expert_offsets(Frame& F, LAS int* off) {
    if (F.tid == 0) { int run = 0; for (int e = 0; e < NE; ++e) { off[e] = run; const int c = (int)__hip_atomic_load(F.ctl + CW_CNT + 64 * e, RLX_AGENT); off[NE + 1 + e] = c; run += (c + 255) & ~255; } off[NE] = run; }
    LDS_WAIT(); __syncthreads();
}
__device__ __forceinline__ void p8_slots(Frame& F, const Args& A) {
    LAS int* off = (LAS int*)F.lds; expert_offsets(F, off);
    const int* toke = (const int*)(ARG_WS + WS_ROUTE + RT_TOKE); const float* tokw = (const float*)(ARG_WS + WS_ROUTE + RT_TOKW); int* tokr = (int*)(ARG_WS + WS_ROUTE + RT_TOKR);
    int* list = (int*)(ARG_WS + WS_ROUTE + RT_LIST); float* slotw = (float*)(ARG_WS + WS_ROUTE + RT_SLOTW);
    const int gt = F.vcu * NTHR + F.tid, NT_ = F.G * NTHR;
    for (int i = gt; i < M * 2; i += NT_) { const int e = toke[i]; const int slot = off[e] + tokr[i]; tokr[i] = slot; list[slot] = i >> 1; slotw[slot] = tokw[i]; }
    const int total = off[NE];
    for (int s = gt; s < total; s += NT_) { int e = 0;
        for (int k = 1; k < NE; ++k) if (s >= off[k]) e = k;
        if (s - off[e] >= off[NE + 1 + e]) { list[s] = -1; slotw[s] = 0.f; } }
    if (F.vcu == 0) { int* tile_e = (int*)(ARG_WS + WS_ROUTE + RT_TILEE);
        for (int t = F.tid; t < 256; t += NTHR) { int e = 0; for (int k = 1; k < NE; ++k) if (t * 256 >= off[k]) e = k; tile_e[t] = (t == 255) ? total / 256 : e; } }
    __syncthreads();
}
struct MoeOrder {
    const int* tile_e; int ntiles, nN, G, c;
    __device__ __forceinline__ bool next(int i, pg8::Unit& u) const { const int L = i * G + c; if (L >= ntiles * nN) return false;
        const int pm = L / nN, pl = L - pm * nN; u.pm = pm; u.pn = tile_e[pm] * nN + pl; return true; }
    __device__ __forceinline__ void a_ready(const pg8::Unit&) const {}
    __device__ __forceinline__ void done(const pg8::Unit&) const {}
};
struct EpiMoeUp {
    static constexpr bool PERM = false, AFTER_DRAIN = false;
    bf16* HID; const float* slotw;
    __device__ __forceinline__ void operator()(const pg8::f32x4 (&acc)[2][2][4][2], const pg8::Unit& u, int wr, int wc, int fr, int fq) const {
        const int slot0 = u.pm * 256 + wr * 64 + fr, col0 = (u.pn & 3) * 128 + wc * 16 + 4 * fq;
#pragma unroll
        for (int ai = 0; ai < 2; ++ai)
#pragma unroll
            for (int m = 0; m < 4; ++m) { const int slot = slot0 + ai * 128 + m * 16; const float w = slotw[slot];
#pragma unroll
                for (int bj = 0; bj < 2; ++bj) { const pg8::f32x4 a = acc[ai][bj][m][0], b = acc[ai][bj][m][1];
                    v2u o; o.x = pk2(siluf(a[0]) * b[0] * w, siluf(a[1]) * b[1] * w); o.y = pk2(siluf(a[2]) * b[2] * w, siluf(a[3]) * b[3] * w);
                    *(v2u*)(HID + (size_t)slot * DE + col0 + bj * 64) = o; } }
    }
};
struct EpiMoeDown {
    static constexpr bool PERM = true, AFTER_DRAIN = false;
    bf16* Y;
    __device__ __forceinline__ void operator()(const pg8::f32x4 (&acc)[2][2][4][2], const pg8::Unit& u, int wr, int wc, int fr, int fq) const {
        const int row0 = u.pm * 256 + wr * 64 + fr, col0 = (u.pn & 7) * 256 + wc * 32 + 8 * fq;
#pragma unroll
        for (int ai = 0; ai < 2; ++ai)
#pragma unroll
            for (int m = 0; m < 4; ++m) { bf16* rowp = Y + (size_t)(row0 + ai * 128 + m * 16) * D + col0;
#pragma unroll
                for (int bj = 0; bj < 2; ++bj) { const pg8::f32x4 v0 = acc[ai][bj][m][0], v1 = acc[ai][bj][m][1];
                    v4u w; w.x = pk2(v0[0], v0[1]); w.y = pk2(v0[2], v0[3]); w.z = pk2(v1[0], v1[1]); w.w = pk2(v1[2], v1[3]);
                    *(v4u*)(rowp + bj * 128) = w; } }
    }
};
__device__ __forceinline__ void p11_final(Frame& F, const Args& A) {
    const float* mod = (const float*)(F.ctl + CW_MOD); const bf16* Y = (const bf16*)(ARG_WS + WS_Y); const bf16* X1 = (const bf16*)(ARG_WS + WS_X1B); const int* tokr = (const int*)(ARG_WS + WS_ROUTE + RT_TOKR); const float* fg = ARG_IN(20);
    float* out = ARG_OUT;
    for (int blk = F.vcu; blk < M / 64; blk += F.G) { const int R0 = blk * 64, b = R0 >> 12, rw = R0 + 8 * F.wave;
        const float* g2p = mod + b * 12288 + 5 * D + 4 * F.lane; const float* fgp = fg + 4 * F.lane;
        v2u xa[8], ya[8], za[8];
#define FN_LOAD(x_, y_, z_, row) do { const int s0_ = tokr[(row) * 2], s1_ = tokr[(row) * 2 + 1]; const GAS v2u* px_ = (const GAS v2u*)(X1 + (size_t)(row) * D) + F.lane; \
            const GAS v2u* p0_ = (const GAS v2u*)(Y + (size_t)s0_ * D) + F.lane; const GAS v2u* p1_ = (const GAS v2u*)(Y + (size_t)s1_ * D) + F.lane; \
            _Pragma("unroll") for (int j = 0; j < 8; ++j) { x_[j] = px_[64 * j]; y_[j] = p0_[64 * j]; z_[j] = p1_[64 * j]; } } while (0)
        FN_LOAD(xa, ya, za, rw);
        for (int rr = 0; rr < 8; ++rr) { const int row = rw + rr; f32x4 v_[8]; float s_ = 0.f;
#pragma unroll
            for (int j = 0; j < 8; ++j) { const f32x4 ys_ = (f32x4){bflo(ya[j].x) + bflo(za[j].x), bfhi(ya[j].x) + bfhi(za[j].x), bflo(ya[j].y) + bflo(za[j].y), bfhi(ya[j].y) + bfhi(za[j].y)};
                v_[j] = (f32x4){bflo(xa[j].x), bfhi(xa[j].x), bflo(xa[j].y), bfhi(xa[j].y)} + *(const f32x4*)(g2p + 256 * j) * ys_; s_ += (v_[j].x * v_[j].x + v_[j].y * v_[j].y) + (v_[j].z * v_[j].z + v_[j].w * v_[j].w); }
            { const int rn = (rr < 7) ? row + 1 : row; FN_LOAD(xa, ya, za, rn); }
            const float r_ = __builtin_amdgcn_rsqf(wave_sum(s_) * (1.f / D) + EPS); GAS f32x4* o_ = (GAS f32x4*)(out + (size_t)row * D) + F.lane;
#pragma unroll
            for (int j = 0; j < 8; ++j) o_[64 * j] = (v_[j] * r_) * *(const f32x4*)(fgp + 256 * j); }
#undef FN_LOAD
    }
}

constexpr int DN_PN = 272, DN_PT = 144;
constexpr int L_KN = 0, L_QN = 17408, L_XT1 = 34816, L_XT2 = 53248, L_KDT = 71680, L_TN = 90112, L_QK = 99328, L_UT = 108544, L_WT = 126976, L_GT = 145408;
constexpr int L_KSW = 131072;
constexpr size_t WS_GATES = WS_ROUTE + 1 * MiB;
constexpr size_t WS_LASTG = WS_ROUTE + 2 * MiB;
constexpr size_t WS_TBUF = 656 * MiB;
constexpr size_t WS_END2 = 672 * MiB;
#ifndef REP_PH
#define REP_PH -1
#endif
#define MFMA16(a, b, c) __builtin_amdgcn_mfma_f32_16x16x32_bf16((a), (b), (c), 0, 0, 0)

__device__ __forceinline__ void conv8_load(const bf16* QKVA, const float* conv_w, long tok0, int tloc0, int w, int col, unsigned (&xw)[11], f32x2 (&cw)[4]) {
#pragma unroll
    for (int i = 0; i < 11; ++i) { const int r = 8 * w - 3 + i; const long rc = (tloc0 + r >= 0) ? (tok0 + r) : tok0; xw[i] = *(const unsigned*)(QKVA + rc * CONVCH + col); if (tloc0 + r < 0) xw[i] = 0u; }
#pragma unroll
    for (int j = 0; j < 4; ++j) cw[j] = *(const f32x2*)(conv_w + j * CONVCH + col);
}
__device__ __forceinline__ void conv8_calc(const unsigned (&xw)[11], const f32x2 (&cw)[4], float (&y0)[8], float (&y1)[8]) {
#pragma unroll
    for (int rr = 0; rr < 8; ++rr) { float a0 = 0.f, a1 = 0.f;
#pragma unroll
        for (int j = 0; j < 4; ++j) { a0 += cw[j].x * bflo(xw[rr + j]); a1 += cw[j].y * bfhi(xw[rr + j]); }
        y0[rr] = siluf(a0); y1[rr] = siluf(a1); }
}
__device__ __forceinline__ void conv8(const bf16* QKVA, const float* conv_w, long tok0, int tloc0, int w, int col, float (&y0)[8], float (&y1)[8]) {
    unsigned xw[11]; f32x2 cw[4]; conv8_load(QKVA, conv_w, tok0, tloc0, w, col, xw, cw); conv8_calc(xw, cw, y0, y1);
}
#define BAR_LDS() do { LDS_WAIT(); __builtin_amdgcn_s_barrier(); asm volatile("" ::: "memory"); } while (0)

__device__ __forceinline__ void dn_prep_solve(Frame& F, const Args& A) {
    const bf16* QKVA = (const bf16*)(ARG_WS + WS_QKVA); const float* small = (const float*)(ARG_WS + WS_SMALL); const float* conv_w = ARG_IN(6);
    float* gates = (float*)(ARG_WS + WS_GATES); float* lastg = (float*)(ARG_WS + WS_LASTG); bf16* TBUF = (bf16*)(ARG_WS + WS_TBUF);
    LAS unsigned char* lds = F.lds; LAS float* gcs = (LAS float*)(lds + LDSCTL_OFF + 1024); LAS float* betas = gcs + 64;
    const int w = F.wave, cp = F.lane, l15 = F.lane & 15, l4 = F.lane >> 4;
    for (int ui = 0; ui < 8; ++ui) { const int unit = F.vcu + F.G * ui; if (unit >= BATCH * NH * NCH) break;
        const int bh = unit >> 6, n = unit & 63, b = bh >> 3, h = bh & 7; const long tok0 = (long)b * SEQ + n * CHUNK;
        if (w == 0) { const float av = small[(tok0 + F.lane) * 32 + h], bv = small[(tok0 + F.lane) * 32 + 8 + h];
            float gc = -__expf(ARG_IN(7)[h]) * softplusf_(av + ARG_IN(8)[h]); const float beta = sigmoidf_(bv);
#pragma unroll
            for (int o = 1; o < 64; o <<= 1) { const float t_ = __shfl_up(gc, o); if (F.lane >= o) gc += t_; }
            gcs[F.lane] = gc; betas[F.lane] = beta; gates[unit * 128 + F.lane] = gc; gates[unit * 128 + 64 + F.lane] = beta; if (F.lane == 63) lastg[unit] = __expf(gc); }
        { float y0[8], y1[8]; conv8(QKVA, conv_w, tok0, n * CHUNK, w, 1024 + h * HD + 2 * cp, y0, y1);
#pragma unroll
          for (int rr = 0; rr < 8; ++rr) { const float rk = rsqrtf(wave_sum(y0[rr] * y0[rr] + y1[rr] * y1[rr]) + EPS); const int r = 8 * w + rr;
              *(LAS unsigned*)(lds + L_KSW + r * 256 + (((cp >> 2) ^ (r & 7)) << 4) + (cp & 3) * 4) = pk2(y0[rr] * rk, y1[rr] * rk); } }
        LDS_WAIT(); __syncthreads();
        { const int ib = w >> 1; LAS float* AL = (LAS float*)(lds + ui * 16384);
#pragma unroll
          for (int jj = 0; jj < 2; ++jj) { const int jb = 2 * (w & 1) + jj;
              if (jb <= ib) { pg8::f32x4 acc = (pg8::f32x4){0.f, 0.f, 0.f, 0.f};
#pragma unroll
                  for (int s = 0; s < 4; ++s) { const int ra = 16 * ib + l15, rb = 16 * jb + l15, c = 4 * s + l4;
                      const bf16x8 a = *(const LAS bf16x8*)(lds + L_KSW + ra * 256 + ((c ^ (ra & 7)) << 4)), bb = *(const LAS bf16x8*)(lds + L_KSW + rb * 256 + ((c ^ (rb & 7)) << 4));
                      acc = MFMA16(a, bb, acc); }
                  const int j = 16 * jb + l15; const float gj = gcs[j];
#pragma unroll
                  for (int rg = 0; rg < 4; ++rg) { const int i = 16 * ib + 4 * l4 + rg;
                      AL[i * 64 + j] = (i > j) ? betas[i] * acc[rg] * __expf(gcs[i] - gj) : 0.f; } } } }
        LDS_WAIT(); __syncthreads();
    }
    { const int unit = F.vcu + F.G * w;
      if (unit < BATCH * NH * NCH) { const LAS float* AL = (const LAS float*)(lds + w * 16384); const int c = F.lane;
          float x[64];
#pragma unroll
          for (int i = 0; i < 64; ++i) { float s0 = (i == c) ? 1.f : 0.f, s1 = 0.f;
#pragma unroll
              for (int j4 = 0; j4 < (i + 3) / 4; ++j4) { const f32x4 a = *(const LAS f32x4*)(AL + i * 64 + 4 * j4);
                  if (4 * j4 + 0 < i) s0 -= a.x * x[4 * j4 + 0];
                  if (4 * j4 + 1 < i) s1 -= a.y * x[4 * j4 + 1];
                  if (4 * j4 + 2 < i) s0 -= a.z * x[4 * j4 + 2];
                  if (4 * j4 + 3 < i) s1 -= a.w * x[4 * j4 + 3]; }
              x[i] = s0 + s1; }
          bf16* Tg = TBUF + (size_t)unit * 4096 + c;
#pragma unroll
          for (int i = 0; i < 64; ++i) Tg[i * 64] = (bf16)f2bf(x[i]); } }
    VM_WAIT(); __syncthreads();
}

__device__ __forceinline__ void dn_prep_mats(Frame& F, const Args& A) {
    const bf16* QKVA = (const bf16*)(ARG_WS + WS_QKVA); const float* conv_w = ARG_IN(6); const float* gates = (const float*)(ARG_WS + WS_GATES); const bf16* TBUF = (const bf16*)(ARG_WS + WS_TBUF);
    bf16* MP = (bf16*)(ARG_WS + WS_MP); bf16* NTg = (bf16*)(ARG_WS + WS_NT); bf16* QP = (bf16*)(ARG_WS + WS_QP); bf16* OL = (bf16*)(ARG_WS + WS_OL);
    LAS unsigned char* lds = F.lds; LAS float* gt = (LAS float*)(lds + L_GT);
    const int w = F.wave, cp = F.lane, l15 = F.lane & 15, l4 = F.lane >> 4;
    unsigned xq[11], xk[11], xv[11]; f32x2 cq[4], ck[4], cv[4]; v4u tv; float g_gc, g_be, g_gl;
#define MATS_LOAD(unit_) do { const int bh_ = (unit_) >> 6, n_ = (unit_) & 63, b_ = bh_ >> 3, h_ = bh_ & 7; const long tok0_ = (long)b_ * SEQ + n_ * CHUNK; \
        conv8_load(QKVA, conv_w, tok0_, n_ * CHUNK, w, h_ * HD + 2 * cp, xq, cq); conv8_load(QKVA, conv_w, tok0_, n_ * CHUNK, w, 1024 + h_ * HD + 2 * cp, xk, ck); conv8_load(QKVA, conv_w, tok0_, n_ * CHUNK, w, 2048 + h_ * HD + 2 * cp, xv, cv); \
        tv = *(const v4u*)(TBUF + (size_t)(unit_) * 4096 + F.tid * 8); g_gc = gates[(unit_) * 128 + cp]; g_be = gates[(unit_) * 128 + 64 + cp]; g_gl = gates[(unit_) * 128 + 63]; } while (0)
    MATS_LOAD(F.vcu);
    for (int ui = 0; ui < 8; ++ui) { const int unit = F.vcu + F.G * ui;
        if (w == 0) { gt[cp] = g_gc; gt[64 + cp] = g_be; gt[128 + cp] = __expf(g_gc); gt[192 + cp] = __expf(g_gl - g_gc); }
        *(LAS v4u*)(lds + L_TN + (F.tid >> 3) * DN_PT + (F.tid & 7) * 16) = tv;
        BAR_LDS();
        for (int rep_ = 0; rep_ < (REP_PH == 33 ? 2 : 1); ++rep_)
        {
            float q0[8], q1[8], k0[8], k1[8], v0[8], v1[8];
            conv8_calc(xq, cq, q0, q1); conv8_calc(xk, ck, k0, k1); conv8_calc(xv, cv, v0, v1);
            if (rep_ == (REP_PH == 33 ? 1 : 0)) { const int un_ = (ui < 7) ? unit + F.G : unit; MATS_LOAD(un_); }
            float x1a[8], x1b[8], x2a[8], x2b[8], kda[8], kdb[8];
#pragma unroll
            for (int rr = 0; rr < 8; ++rr) { const int r = 8 * w + rr;
                const float rq = __builtin_amdgcn_rsqf(wave_sum(q0[rr] * q0[rr] + q1[rr] * q1[rr]) + EPS) * 0.08838834764831845f, rk = __builtin_amdgcn_rsqf(wave_sum(k0[rr] * k0[rr] + k1[rr] * k1[rr]) + EPS);
                const float be = gt[64 + r], eg = gt[128 + r], ek = gt[192 + r];
                const float ka = k0[rr] * rk, kb = k1[rr] * rk;
                *(LAS unsigned*)(lds + L_QN + r * DN_PN + cp * 4) = pk2(q0[rr] * rq, q1[rr] * rq);
                *(LAS unsigned*)(lds + L_KN + r * DN_PN + cp * 4) = pk2(ka, kb);
                x1a[rr] = v0[rr] * be; x1b[rr] = v1[rr] * be; x2a[rr] = ka * be * eg; x2b[rr] = kb * be * eg; kda[rr] = ka * ek; kdb[rr] = kb * ek; }
#define DN_PACK8(x) (v4u){pk2((x)[0], (x)[1]), pk2((x)[2], (x)[3]), pk2((x)[4], (x)[5]), pk2((x)[6], (x)[7])}
            *(LAS v4u*)(lds + L_XT1 + (2 * cp) * DN_PT + w * 16) = DN_PACK8(x1a); *(LAS v4u*)(lds + L_XT1 + (2 * cp + 1) * DN_PT + w * 16) = DN_PACK8(x1b);
            *(LAS v4u*)(lds + L_XT2 + (2 * cp) * DN_PT + w * 16) = DN_PACK8(x2a); *(LAS v4u*)(lds + L_XT2 + (2 * cp + 1) * DN_PT + w * 16) = DN_PACK8(x2b);
            *(LAS v4u*)(lds + L_KDT + (2 * cp) * DN_PT + w * 16) = DN_PACK8(kda); *(LAS v4u*)(lds + L_KDT + (2 * cp + 1) * DN_PT + w * 16) = DN_PACK8(kdb);
#undef DN_PACK8
        }
        BAR_LDS();
        for (int rep_ = 0; rep_ < (REP_PH == 34 ? 2 : 1); ++rep_)
        {
            const int jb = w >> 1;
#pragma unroll
            for (int ii = 0; ii < 2; ++ii) { const int ib = 2 * (w & 1) + ii; pg8::f32x4 acc = (pg8::f32x4){0.f, 0.f, 0.f, 0.f};
                if (ib >= jb) {
#pragma unroll
                    for (int s = 0; s < 4; ++s) { const bf16x8 a = *(const LAS bf16x8*)(lds + L_KN + (16 * jb + l15) * DN_PN + (8 * l4 + 32 * s) * 2), bb = *(const LAS bf16x8*)(lds + L_QN + (16 * ib + l15) * DN_PN + (8 * l4 + 32 * s) * 2);
                        acc = MFMA16(a, bb, acc); } }
                const int i = 16 * ib + l15; const float gi = gt[i]; float o[4];
#pragma unroll
                for (int rg = 0; rg < 4; ++rg) { const int j = 16 * jb + 4 * l4 + rg; o[rg] = (i >= j) ? acc[rg] * __expf(gi - gt[j]) : 0.f; }
                *(LAS v2u*)(lds + L_QK + i * DN_PT + (16 * jb + 4 * l4) * 2) = (v2u){pk2(o[0], o[1]), pk2(o[2], o[3])}; }
            bf16x8 ta[4][2], b1[2], b2[2];
#pragma unroll
            for (int it = 0; it < 4; ++it)
#pragma unroll
                for (int s = 0; s < 2; ++s) ta[it][s] = *(const LAS bf16x8*)(lds + L_TN + (16 * it + l15) * DN_PT + (8 * l4 + 32 * s) * 2);
#pragma unroll
            for (int s = 0; s < 2; ++s) { b1[s] = *(const LAS bf16x8*)(lds + L_XT1 + (16 * w + l15) * DN_PT + (8 * l4 + 32 * s) * 2); b2[s] = *(const LAS bf16x8*)(lds + L_XT2 + (16 * w + l15) * DN_PT + (8 * l4 + 32 * s) * 2); }
#pragma unroll
            for (int it = 0; it < 4; ++it) { pg8::f32x4 au = (pg8::f32x4){0.f, 0.f, 0.f, 0.f}, aw = au;
#pragma unroll
                for (int s = 0; s < 2; ++s) { au = MFMA16(ta[it][s], b1[s], au); aw = MFMA16(ta[it][s], b2[s], aw); }
                *(LAS v2u*)(lds + L_UT + (16 * w + l15) * DN_PT + (16 * it + 4 * l4) * 2) = (v2u){pk2(au[0], au[1]), pk2(au[2], au[3])};
                *(LAS v2u*)(lds + L_WT + (16 * w + l15) * DN_PT + (16 * it + 4 * l4) * 2) = (v2u){pk2(aw[0], aw[1]), pk2(aw[2], aw[3])}; }
        }
        BAR_LDS();
        for (int rep_ = 0; rep_ < (REP_PH == 35 ? 2 : 1); ++rep_)
        {
            bf16x8 wa[2], ua[2], ka[2];
#pragma unroll
            for (int s = 0; s < 2; ++s) { wa[s] = *(const LAS bf16x8*)(lds + L_WT + (16 * w + l15) * DN_PT + (8 * l4 + 32 * s) * 2); ua[s] = *(const LAS bf16x8*)(lds + L_UT + (16 * w + l15) * DN_PT + (8 * l4 + 32 * s) * 2);
                ka[s] = *(const LAS bf16x8*)(lds + L_KDT + (16 * w + l15) * DN_PT + (8 * l4 + 32 * s) * 2); }
            bf16* MPu = MP + (size_t)unit * 16384; bf16* NTu = NTg + (size_t)unit * 16384; bf16* QPu = QP + (size_t)unit * 8192; bf16* OLu = OL + (size_t)unit * 8192;
#pragma unroll
            for (int bt = 0; bt < 8; ++bt) {
                bf16x8 kb[2], ub[2];
#pragma unroll
                for (int s = 0; s < 2; ++s) { kb[s] = *(const LAS bf16x8*)(lds + L_KDT + (16 * bt + l15) * DN_PT + (8 * l4 + 32 * s) * 2); ub[s] = *(const LAS bf16x8*)(lds + L_UT + (16 * bt + l15) * DN_PT + (8 * l4 + 32 * s) * 2); }
                pg8::f32x4 am = (pg8::f32x4){0.f, 0.f, 0.f, 0.f}, an = am;
#pragma unroll
                for (int s = 0; s < 2; ++s) { am = MFMA16(wa[s], kb[s], am); an = MFMA16(ka[s], ub[s], an); }
                *(v2u*)(MPu + (16 * bt + l15) * 128 + 16 * w + 4 * l4) = (v2u){pk2(-am[0], -am[1]), pk2(-am[2], -am[3])};
                *(v2u*)(NTu + (16 * bt + l15) * 128 + 16 * w + 4 * l4) = (v2u){pk2(an[0], an[1]), pk2(an[2], an[3])}; }
#pragma unroll
            for (int bt = 0; bt < 4; ++bt) {
                bf16x8 qb[2];
#pragma unroll
                for (int s = 0; s < 2; ++s) qb[s] = *(const LAS bf16x8*)(lds + L_QK + (16 * bt + l15) * DN_PT + (8 * l4 + 32 * s) * 2);
                pg8::f32x4 aq = (pg8::f32x4){0.f, 0.f, 0.f, 0.f}, ao = aq;
#pragma unroll
                for (int s = 0; s < 2; ++s) { aq = MFMA16(wa[s], qb[s], aq); ao = MFMA16(ua[s], qb[s], ao); }
                const int i = 16 * bt + l15; const float eg = gt[128 + i];
                const v2u qv = *(const LAS v2u*)(lds + L_QN + i * DN_PN + (16 * w + 4 * l4) * 2);
                *(v2u*)(QPu + i * 128 + 16 * w + 4 * l4) = (v2u){pk2(bflo(qv.x) * eg - aq[0], bfhi(qv.x) * eg - aq[1]), pk2(bflo(qv.y) * eg - aq[2], bfhi(qv.y) * eg - aq[3])};
                *(v2u*)(OLu + i * 128 + 16 * w + 4 * l4) = (v2u){pk2(ao[0], ao[1]), pk2(ao[2], ao[3])}; }
        }
        BAR_LDS();
    }
}

#undef MATS_LOAD
constexpr int SC_P = 272;
__device__ __forceinline__ void dn_scan(Frame& F, const Args& A) {
    const bf16* MP = (const bf16*)(ARG_WS + WS_MP); const bf16* NTg = (const bf16*)(ARG_WS + WS_NT); const float* lastg = (const float*)(ARG_WS + WS_LASTG); bf16* SB = (bf16*)(ARG_WS + WS_SB);
    LAS unsigned char* lds = F.lds; const int w = F.wave, l15 = F.lane & 15, l4 = F.lane >> 4;
    for (int su = F.vcu; su < BATCH * NH * 4; su += F.G) { const int bh = su >> 2, sl = su & 3;
        pg8::f32x4 acc[2]; acc[0] = (pg8::f32x4){0.f, 0.f, 0.f, 0.f}; acc[1] = acc[0];
        bf16x8 ma[3][4]; v2u nt[3][2]; float lastv[3];
#define SC_LOAD(slot, u_) do { const bf16* mp_ = MP + (size_t)(u_) * 16384 + (16 * w + l15) * 128 + 8 * l4; \
            _Pragma("unroll") for (int s = 0; s < 4; ++s) ma[slot][s] = *(const bf16x8*)(mp_ + 32 * s); \
            _Pragma("unroll") for (int t = 0; t < 2; ++t) nt[slot][t] = *(const v2u*)(NTg + (size_t)(u_) * 16384 + (32 * sl + 16 * t + l15) * 128 + 16 * w + 4 * l4); \
            lastv[slot] = lastg[(u_)]; } while (0)
#define SC_STEP(slot, n_) do { const int u = bh * 64 + (n_); LAS unsigned char* st = lds + ((n_) & 1) * (32 * SC_P); \
            v2u sv[2]; \
            _Pragma("unroll") for (int t = 0; t < 2; ++t) { sv[t] = (v2u){pk2(acc[t][0], acc[t][1]), pk2(acc[t][2], acc[t][3])}; \
                *(LAS v2u*)(st + (16 * t + l15) * SC_P + (16 * w + 4 * l4) * 2) = sv[t]; } \
            bf16x8 mc[4]; v2u nc[2]; const float lc = lastv[slot]; \
            _Pragma("unroll") for (int s = 0; s < 4; ++s) mc[s] = ma[slot][s]; \
            nc[0] = nt[slot][0]; nc[1] = nt[slot][1]; \
            { const int un_ = ((n_) + 3 < NCH) ? u + 3 : bh * 64 + NCH - 1; SC_LOAD(slot, un_); }     \
            _Pragma("unroll") for (int t = 0; t < 2; ++t) *(v2u*)(SB + (size_t)u * 16384 + (32 * sl + 16 * t + l15) * 128 + 16 * w + 4 * l4) = sv[t]; \
            LDS_WAIT(); __builtin_amdgcn_s_barrier(); asm volatile("" ::: "memory"); \
            _Pragma("unroll") for (int t = 0; t < 2; ++t) { acc[t] = (pg8::f32x4){acc[t][0] * lc + bflo(nc[t].x), acc[t][1] * lc + bfhi(nc[t].x), acc[t][2] * lc + bflo(nc[t].y), acc[t][3] * lc + bfhi(nc[t].y)}; \
                _Pragma("unroll") for (int s = 0; s < 4; ++s) { const bf16x8 sb = *(const LAS bf16x8*)(st + (16 * t + l15) * SC_P + (8 * l4 + 32 * s) * 2); acc[t] = MFMA16(mc[s], sb, acc[t]); } } } while (0)
        SC_LOAD(0, bh * 64); SC_LOAD(1, bh * 64 + 1); SC_LOAD(2, bh * 64 + 2);
        for (int n = 0; n < NCH - 1; n += 3) { SC_STEP(0, n); SC_STEP(1, n + 1); SC_STEP(2, n + 2); }
        SC_STEP(0, NCH - 1);
#undef SC_STEP
#undef SC_LOAD
        __syncthreads();
    }
}

__device__ __forceinline__ void dn_out(Frame& F, const Args& A) {
    const bf16* SB = (const bf16*)(ARG_WS + WS_SB); const bf16* QP = (const bf16*)(ARG_WS + WS_QP); const bf16* OL = (const bf16*)(ARG_WS + WS_OL); const bf16* Z = (const bf16*)(ARG_WS + WS_Z);
    const float* onorm = ARG_IN(9); bf16* MIX = (bf16*)(ARG_WS + WS_H);
    LAS float* part = (LAS float*)F.lds;
    const int w = F.wave, l15 = F.lane & 15, l4 = F.lane >> 4;
    for (int ui = 0; ui < 8; ++ui) { const int unit = F.vcu + F.G * ui; if (unit >= BATCH * NH * NCH) break;
        const int bh = unit >> 6, n = unit & 63, b = bh >> 3, h = bh & 7; const long tok0 = (long)b * SEQ + n * CHUNK;
        bf16x8 sa[4];
#pragma unroll
        for (int s = 0; s < 4; ++s) sa[s] = *(const bf16x8*)(SB + (size_t)unit * 16384 + (16 * w + l15) * 128 + 8 * l4 + 32 * s);
        pg8::f32x4 o[4]; float ss[4];
#pragma unroll
        for (int it = 0; it < 4; ++it) { pg8::f32x4 acc = (pg8::f32x4){0.f, 0.f, 0.f, 0.f};
#pragma unroll
            for (int s = 0; s < 4; ++s) { const bf16x8 qb = *(const bf16x8*)(QP + (size_t)unit * 8192 + (16 * it + l15) * 128 + 8 * l4 + 32 * s); acc = MFMA16(sa[s], qb, acc); }
            const v2u ol = *(const v2u*)(OL + (size_t)unit * 8192 + (16 * it + l15) * 128 + 16 * w + 4 * l4);
            acc = (pg8::f32x4){acc[0] + bflo(ol.x), acc[1] + bfhi(ol.x), acc[2] + bflo(ol.y), acc[3] + bfhi(ol.y)};
            o[it] = acc; float s2 = (acc[0] * acc[0] + acc[1] * acc[1]) + (acc[2] * acc[2] + acc[3] * acc[3]);
            s2 += __shfl_xor(s2, 16); s2 += __shfl_xor(s2, 32); ss[it] = s2; }
        if (l4 == 0) {
#pragma unroll
            for (int it = 0; it < 4; ++it) part[w * 64 + 16 * it + l15] = ss[it]; }
        LDS_WAIT(); __syncthreads();
        const f32x4 gn = *(const f32x4*)(onorm + 16 * w + 4 * l4);
#pragma unroll
        for (int it = 0; it < 4; ++it) { const int i = 16 * it + l15; float tot = 0.f;
#pragma unroll
            for (int ww = 0; ww < 8; ++ww) tot += part[ww * 64 + i];
            const float rn = rsqrtf(tot * (1.f / HD) + EPS);
            const v2u zv = *(const v2u*)(Z + (tok0 + i) * 1024 + h * HD + 16 * w + 4 * l4);
            const float r0 = o[it][0] * rn * gn.x * siluf(bflo(zv.x)), r1 = o[it][1] * rn * gn.y * siluf(bfhi(zv.x)), r2 = o[it][2] * rn * gn.z * siluf(bflo(zv.y)), r3 = o[it][3] * rn * gn.w * siluf(bfhi(zv.y));
            *(v2u*)(MIX + (tok0 + i) * D + h * HD + 16 * w + 4 * l4) = (v2u){pk2(r0, r1), pk2(r2, r3)}; }
        __syncthreads();
    }
}

#define IN(k) (lo <= (k) && (k) < hi)
__global__ void __launch_bounds__(NTHR, 2) fwd(Args args) {
    extern __shared__ __attribute__((aligned(16))) unsigned char lds[];
    Frame F;
    F.lds = (LAS unsigned char*)lds; F.MISC = (volatile LAS unsigned*)(F.lds + MISC_OFF);
    F.tid = threadIdx.x; F.lane = F.tid & 63; F.wave = __builtin_amdgcn_readfirstlane(F.tid >> 6);
    F.G = gridDim.x; { const int bx = blockIdx.x; F.vcu = (F.G % 8 == 0) ? (bx % 8) * (F.G / 8) + bx / 8 : bx; }
    F.gw = F.vcu * NWAVES + F.wave; F.NGW = F.G * NWAVES;
    F.ctl = (unsigned*)(ARG_WS + WS_CTL);
    for (int u = F.tid; u < (LDS_BYTES - LDSCTL_OFF) / 4; u += NTHR) ((LAS unsigned*)(F.lds + LDSCTL_OFF))[u] = 0u;
    __syncthreads();
    const int lo = args.ph_lo, hi = args.ph_hi;
    XcdBarrier bar; bar.bar = F.ctl + CW_BAR; bar.x = 0; bar.st = nullptr;
    if (hi - lo > 1) bar = xcd_barrier_post(F.ctl + CW_BAR, F.MISC + 8);
#define SEAM(k) do { if (hi > (k) + 1) xcd_barrier(bar); } while (0)
    unsigned char* ws = ARG_WS;
    const float* mod = (const float*)(F.ctl + CW_MOD);

#ifndef REP_PH
#define REP_PH -1
#endif
#define RUN_PHASE(k, BODY) do { if (IN(k)) { BODY; if (REP_PH == (k)) { __syncthreads(); BODY; } SEAM(k); } } while (0)
#define BODY0 p0_prologue(F, args)
#define BODY1 norm_rows_skinny<2, false, false>(F, args, ARG_IN(0), ARG_IN(4), mod, mod + D, (bf16*)(ws + WS_H), (const bf16*)(ws + WS_WST), (float*)(ws + WS_SMALL), 32)
#define BODY2 do { pg8::Gemm g{(const pg8::bf16_t*)(ws + WS_H), (const pg8::bf16_t*)(ws + WS_WINT), M, NBIG, D}; pg8::StaticOrder S; S.init(M, NBIG, F.G, (int)blockIdx.x); \
        EpiProj E{(bf16*)(ws + WS_QKVA), (bf16*)(ws + WS_Z), (bf16*)(ws + WS_QKVB)}; \
        pg8::gemm_phase<EpiProj, pg8::StaticOrder, true, true>(F.lds, g, S, E); } while (0)
#define BODY3 do { p4_normmax(F, args); __syncthreads(); dn_prep_solve(F, args); if (REP_PH == 31) dn_prep_solve(F, args); dn_prep_mats(F, args); if (REP_PH == 32) dn_prep_mats(F, args); } while (0)
#define BODY4 do { dn_scan(F, args); __syncthreads(); p3_cumf(F, args); } while (0)
#define BODY5 do { p4_attn(F, args, (char*)lds); __syncthreads(); dn_out(F, args); if (REP_PH == 51) dn_out(F, args); } while (0)
#define BODY5B do { __syncthreads(); if (F.tid == 0) atomicExch(F.ctl + CW_ATTNQ, 0u); } while (0)
#define BODY6 do { pg8::Gemm g{(const pg8::bf16_t*)(ws + WS_H), (const pg8::bf16_t*)(ws + WS_WOUTT), M, D, D}; pg8::StaticOrder S; S.init(M, D, F.G, (int)blockIdx.x); \
        EpiMix E{ARG_IN(0), mod, (bf16*)(ws + WS_X1B)}; \
        pg8::gemm_phase<EpiMix, pg8::StaticOrder, true, true>(F.lds, g, S, E); } while (0)
#define BODY7 norm_rows_skinny<3, true, true>(F, args, (const bf16*)(ws + WS_X1B), ARG_IN(12), mod + 3 * D, mod + 4 * D, (bf16*)(ws + WS_H), (const bf16*)(ws + WS_WRT), (float*)(ws + WS_RL), 48)
#define BODY8 p8_slots(F, args)
#define BODY9 do { const int* tile_e = (const int*)(ws + WS_ROUTE + RT_TILEE); \
        pg8::Gemm g{(const pg8::bf16_t*)(ws + WS_H), (const pg8::bf16_t*)(ws + WS_W13T), SLOT_CAP, NE * 1024, D}; \
        MoeOrder S{tile_e, tile_e[255], 4, F.G, F.vcu}; \
        EpiMoeUp E{(bf16*)(ws + WS_HID), (const float*)(ws + WS_ROUTE + RT_SLOTW)}; \
        pg8::gemm_phase_g<EpiMoeUp, MoeOrder, true, true>(F.lds, g, S, E, (const int*)(ws + WS_ROUTE + RT_LIST)); } while (0)
#define BODY10 do { const int* tile_e = (const int*)(ws + WS_ROUTE + RT_TILEE); \
        pg8::Gemm g{(const pg8::bf16_t*)(ws + WS_HID), (const pg8::bf16_t*)(ws + WS_W2T), SLOT_CAP, NE * D, DE}; \
        MoeOrder S{tile_e, tile_e[255], 8, F.G, F.vcu}; \
        EpiMoeDown E{(bf16*)(ws + WS_Y)}; \
        pg8::gemm_phase<EpiMoeDown, MoeOrder, true, true>(F.lds, g, S, E); } while (0)
#define BODY11 p11_final(F, args)
    RUN_PHASE(0, BODY0); RUN_PHASE(1, BODY1); RUN_PHASE(2, BODY2); RUN_PHASE(3, BODY3); RUN_PHASE(4, BODY4); RUN_PHASE(5, BODY5);
    RUN_PHASE(6, BODY6); RUN_PHASE(7, BODY7); RUN_PHASE(8, BODY8); RUN_PHASE(9, BODY9); RUN_PHASE(10, BODY10); RUN_PHASE(11, BODY11);
}
constexpr int NPHASE = 12;

extern "C" void kernel_launch(void* const* d_in, const int* in_sizes, int n_in, void* d_out, int out_size, void* d_ws, size_t ws_size, hipStream_t stream) {
    static int grid = 0;
    if (grid == 0) {
        if (n_in != 21 || out_size != M * D || ws_size < WS_END2) { fprintf(stderr, "kernel_launch: unexpected shapes (n_in %d out %d ws %zu)\n", n_in, out_size, ws_size); grid = -1; return; }
        int dev = 0, cus = 0;
        if (hipGetDevice(&dev) != hipSuccess || hipDeviceGetAttribute(&cus, hipDeviceAttributeMultiprocessorCount, dev) != hipSuccess) { grid = -1; return; }
        if (hipFuncSetAttribute((const void*)fwd, hipFuncAttributeMaxDynamicSharedMemorySize, LDS_BYTES) != hipSuccess) { fprintf(stderr, "kernel_launch: hipFuncSetAttribute failed\n"); grid = -1; return; }
        int per_cu = 0; (void)hipOccupancyMaxActiveBlocksPerMultiprocessor(&per_cu, (const void*)fwd, NTHR, LDS_BYTES); (void)hipGetLastError();
        grid = cus;
    }
    if (grid < 0) return;
    if (hipMemsetAsync((char*)d_ws + WS_CTL, 0, CTL_ZERO_BYTES, stream) != hipSuccess) return;
    Args a{};
    for (int i = 0; i < 21; ++i) a.in[i] = (const float*)d_in[i];
    a.out = (float*)d_out; a.ws = (unsigned char*)d_ws;
#ifdef PROBE_PH
    a.ph_lo = 0; a.ph_hi = PROBE_PH + 1; hipLaunchKernelGGL(fwd, dim3(grid), dim3(NTHR), LDS_BYTES, stream, a);
    (void)hipMemsetAsync((char*)d_ws + WS_CTL + 4 * 4096, 0, 4 * (10240 - 4096), stream);
    (void)hipMemsetAsync((char*)d_ws + WS_CTL + 4 * CW_ATTNQ, 0, 4, stream);
    a.ph_lo = PROBE_PH; a.ph_hi = NPHASE; hipLaunchKernelGGL(fwd, dim3(grid), dim3(NTHR), LDS_BYTES, stream, a);
#else
    a.ph_lo = 0; a.ph_hi = NPHASE; hipLaunchKernelGGL(fwd, dim3(grid), dim3(NTHR), LDS_BYTES, stream, a);
#endif
}
```
